# Optimizing an MI355X kernel written in HIP

```python
import math
import jax, jax.numpy as jnp
from jax import lax
import numpy as np

D_MODEL = 1024
BATCH = 2
SEQ = 16384
DEPTH = 1
DEC_BATCH = 16
DEC_SEQ = 64
PAST_LEN = 4096

CHUNK = 64
GLA_HEADS = 4
GLA_DK = 64
GLA_DV = 128
GLA_KEY = GLA_HEADS * GLA_DK
GLA_VAL = GLA_HEADS * GLA_DV
GLA_GATE_RANK = 16
GLA_GATE_TAU = 16.0
S5_WIDTH = 512
S5_GROUP = 16
S5_GROUPS = S5_WIDTH // S5_GROUP
S5_STATE = 64
D_FF = 2816
EPS = 1e-6
IN_SIZES = (GLA_KEY, GLA_KEY, GLA_VAL, GLA_VAL, GLA_GATE_RANK, S5_WIDTH, D_MODEL, D_MODEL)
IN_COLS = sum(IN_SIZES)

kernel_name = "hybrid_gla_s5_macaron_stream_step"


def _rmsnorm(x, g):
    xf = x.astype(jnp.float32)
    xf = xf * lax.rsqrt(jnp.mean(xf * xf, axis=-1, keepdims=True) + EPS)
    return (xf * g.astype(jnp.float32)).astype(x.dtype)


def _swiglu(x, w_gate, w_up, w_down):
    return (jax.nn.silu(x @ w_gate) * (x @ w_up)) @ w_down


def _heads(z, n):
    b, t, _ = z.shape
    return z.reshape(b, t, n, -1).transpose(0, 2, 1, 3)


def _gla_chunked(q, k, v, log_a, s0, chunk):
    bsz, nh, t, dk = q.shape
    dv = v.shape[-1]
    n = t // chunk

    def to_chunks(z):
        return jnp.moveaxis(z.reshape(bsz, nh, n, chunk, z.shape[-1]), 2, 0)

    causal = jnp.tril(jnp.ones((chunk, chunk), dtype=bool))[:, :, None]

    def step(s, inp):
        qi, ki, vi, ai = inp
        b = jnp.cumsum(ai, axis=2)
        diff = b[:, :, :, None, :] - b[:, :, None, :, :]
        decay = jnp.exp(jnp.where(causal, diff, -jnp.inf))
        scores = jnp.einsum('bhtd,bhsd,bhtsd->bhts', qi, ki, decay)
        o = jnp.einsum('bhts,bhse->bhte', scores, vi) + jnp.einsum('bhtd,bhde->bhte', qi * jnp.exp(b), s)
        b_last = b[:, :, -1:, :]
        s_new = jnp.exp(b_last[:, :, 0, :])[..., None] * s + jnp.einsum('bhsd,bhse->bhde', ki * jnp.exp(b_last - b), vi)
        return s_new, o

    s_fin, oc = lax.scan(step, s0, (to_chunks(q), to_chunks(k), to_chunks(v), to_chunks(log_a)))
    o = jnp.moveaxis(oc, 0, 2).reshape(bsz, nh, t, dv)
    return o, s_fin


def _s5_scan(u, lam_re, lam_im, log_dt, b_re, b_im, c_re, c_im, d_skip, x0):
    f32 = jnp.float32
    bsz, t, _ = u.shape
    uf = u.astype(f32)
    ug = uf.reshape(bsz, t, S5_GROUPS, S5_GROUP)
    lr, li = lam_re.astype(f32), lam_im.astype(f32)
    dt = jnp.exp(log_dt.astype(f32))[:, None]
    mag = jnp.exp(lr * dt)
    ab_re, ab_im = mag * jnp.cos(li * dt), mag * jnp.sin(li * dt)
    nr, ni = ab_re - 1.0, ab_im
    den = lr * lr + li * li
    f_re = (nr * lr + ni * li) / den
    f_im = (ni * lr - nr * li) / den
    br, bi = b_re.astype(f32), b_im.astype(f32)
    bb_re = f_re[..., None] * br - f_im[..., None] * bi
    bb_im = f_re[..., None] * bi + f_im[..., None] * br
    bu_re = jnp.einsum('btgh,gph->btgp', ug, bb_re)
    bu_im = jnp.einsum('btgh,gph->btgp', ug, bb_im)
    x0r, x0i = x0[..., 0].astype(f32), x0[..., 1].astype(f32)
    bu_re = bu_re.at[:, 0].add(ab_re * x0r - ab_im * x0i)
    bu_im = bu_im.at[:, 0].add(ab_re * x0i + ab_im * x0r)
    a_re = jnp.broadcast_to(ab_re, bu_re.shape)
    a_im = jnp.broadcast_to(ab_im, bu_im.shape)

    def combine(e1, e2):
        a1r, a1i, b1r, b1i = e1
        a2r, a2i, b2r, b2i = e2
        return (a1r * a2r - a1i * a2i,
                a1r * a2i + a1i * a2r,
                a2r * b1r - a2i * b1i + b2r,
                a2r * b1i + a2i * b1r + b2i)

    _, _, xr, xi = lax.associative_scan(combine, (a_re, a_im, bu_re, bu_im), axis=1)
    y = jnp.einsum('gjp,btgp->btgj', c_re.astype(f32), xr) - jnp.einsum('gjp,btgp->btgj', c_im.astype(f32), xi)
    y = y.reshape(bsz, t, S5_WIDTH) + d_skip.astype(f32) * uf
    x_last = jnp.stack([xr[:, -1], xi[:, -1]], axis=-1)
    return y, x_last


def _layer(x, s_gla, s_s5, chunk, p):
    f32 = jnp.float32
    bsz, t, _ = x.shape
    h = x + 0.5 * _swiglu(_rmsnorm(x, p['g_ffn1']), p['w_ffn1_gate'], p['w_ffn1_up'], p['w_ffn1_down'])
    u = _rmsnorm(h, p['g_mix'])
    z = u @ p['w_in']
    splits = [sum(IN_SIZES[:i + 1]) for i in range(len(IN_SIZES) - 1)]
    q, k, v, r, ga, us5, gm_gla, gm_s5 = jnp.split(z, splits, axis=-1)
    log_a = jax.nn.log_sigmoid((ga @ p['w_gate_up'] + p['b_gate']).astype(f32)) / GLA_GATE_TAU
    qh = _heads(q.astype(f32), GLA_HEADS) * (GLA_DK ** -0.5)
    kh = _heads(k.astype(f32), GLA_HEADS)
    vh = _heads(v.astype(f32), GLA_HEADS)
    ah = _heads(log_a, GLA_HEADS)
    o, s_gla_new = _gla_chunked(qh, kh, vh, ah, s_gla.astype(f32), chunk)
    o = o.transpose(0, 2, 1, 3)
    o = o * lax.rsqrt(jnp.mean(o * o, axis=-1, keepdims=True) + EPS)
    o = o.reshape(bsz, t, GLA_VAL) * p['g_gla_head'].astype(f32)
    y_gla = (o * jax.nn.silu(r.astype(f32))).astype(h.dtype) @ p['w_gla_out']
    ys5, s_s5_new = _s5_scan(us5, p['s5_lam_re'], p['s5_lam_im'], p['s5_log_dt'], p['s5_b_re'], p['s5_b_im'],
                             p['s5_c_re'], p['s5_c_im'], p['s5_d'], s_s5)
    g5 = jax.nn.gelu(ys5).astype(h.dtype)
    y_s5 = ((g5 @ p['w_glu_a']) * jax.nn.sigmoid(g5 @ p['w_glu_b'])) @ p['w_s5_out']
    m = jax.nn.sigmoid(gm_gla) * y_gla + jax.nn.sigmoid(gm_s5) * y_s5
    h = h + m @ p['w_out']
    h = h + 0.5 * _swiglu(_rmsnorm(h, p['g_ffn2']), p['w_ffn2_gate'], p['w_ffn2_up'], p['w_ffn2_down'])
    return h, s_gla_new, s_s5_new


def setup_inputs(seed: int = 0) -> dict:
    key = jax.random.key(seed)
    ks = jax.random.split(key, 40)
    f32 = jnp.float32

    def nrm(k, shape, scale):
        return jax.random.normal(k, shape, f32) * scale

    def gain(k, n):
        return 1.0 + 0.05 * jax.random.normal(k, (n,), f32)

    lam_im_base = math.pi * jnp.arange(S5_STATE, dtype=f32)[None, :]
    return {
        'x_prompt': nrm(ks[0], (BATCH, SEQ, D_MODEL), 1.0),
        'x_sample': nrm(ks[1], (DEC_BATCH, DEC_SEQ, D_MODEL), 1.0),
        'state_gla': nrm(ks[2], (DEC_BATCH, GLA_HEADS, GLA_DK, GLA_DV), 0.5),
        'state_s5': nrm(ks[3], (DEC_BATCH, S5_GROUPS, S5_STATE, 2), 0.5),
        'g_ffn1': gain(ks[4], D_MODEL),
        'w_ffn1_gate': nrm(ks[5], (D_MODEL, D_FF), D_MODEL ** -0.5),
        'w_ffn1_up': nrm(ks[6], (D_MODEL, D_FF), D_MODEL ** -0.5),
        'w_ffn1_down': nrm(ks[7], (D_FF, D_MODEL), D_FF ** -0.5),
        'g_mix': gain(ks[8], D_MODEL),
        'w_in': nrm(ks[9], (D_MODEL, IN_COLS), D_MODEL ** -0.5),
        'w_gate_up': nrm(ks[10], (GLA_GATE_RANK, GLA_KEY), GLA_GATE_RANK ** -0.5),
        'b_gate': nrm(ks[11], (GLA_KEY,), 0.1),
        'g_gla_head': gain(ks[12], GLA_VAL),
        'w_gla_out': nrm(ks[13], (GLA_VAL, D_MODEL), GLA_VAL ** -0.5),
        's5_lam_re': -0.5 + nrm(ks[14], (S5_GROUPS, S5_STATE), 0.01),
        's5_lam_im': lam_im_base + nrm(ks[15], (S5_GROUPS, S5_STATE), 0.01),
        's5_log_dt': jax.random.uniform(ks[16], (S5_GROUPS,), f32, math.log(1e-3), math.log(1e-1)),
        's5_b_re': nrm(ks[17], (S5_GROUPS, S5_STATE, S5_GROUP), (0.5 / S5_GROUP) ** 0.5),
        's5_b_im': nrm(ks[18], (S5_GROUPS, S5_STATE, S5_GROUP), (0.5 / S5_GROUP) ** 0.5),
        's5_c_re': nrm(ks[19], (S5_GROUPS, S5_GROUP, S5_STATE), (0.5 / S5_STATE) ** 0.5),
        's5_c_im': nrm(ks[20], (S5_GROUPS, S5_GROUP, S5_STATE), (0.5 / S5_STATE) ** 0.5),
        's5_d': nrm(ks[21], (S5_WIDTH,), 1.0),
        'w_glu_a': nrm(ks[22], (S5_WIDTH, S5_WIDTH), S5_WIDTH ** -0.5),
        'w_glu_b': nrm(ks[23], (S5_WIDTH, S5_WIDTH), S5_WIDTH ** -0.5),
        'w_s5_out': nrm(ks[24], (S5_WIDTH, D_MODEL), S5_WIDTH ** -0.5),
        'w_out': nrm(ks[25], (D_MODEL, D_MODEL), D_MODEL ** -0.5),
        'g_ffn2': gain(ks[26], D_MODEL),
        'w_ffn2_gate': nrm(ks[27], (D_MODEL, D_FF), D_MODEL ** -0.5),
        'w_ffn2_up': nrm(ks[28], (D_MODEL, D_FF), D_MODEL ** -0.5),
        'w_ffn2_down': nrm(ks[29], (D_FF, D_MODEL), D_FF ** -0.5),
        'g_final': gain(ks[30], D_MODEL),
    }


def reference(x_prompt, x_sample, state_gla, state_s5, g_ffn1, w_ffn1_gate, w_ffn1_up, w_ffn1_down,
              g_mix, w_in, w_gate_up, b_gate, g_gla_head, w_gla_out, s5_lam_re, s5_lam_im, s5_log_dt,
              s5_b_re, s5_b_im, s5_c_re, s5_c_im, s5_d, w_glu_a, w_glu_b, w_s5_out, w_out,
              g_ffn2, w_ffn2_gate, w_ffn2_up, w_ffn2_down, g_final):
    p = {
        'g_ffn1': g_ffn1, 'w_ffn1_gate': w_ffn1_gate, 'w_ffn1_up': w_ffn1_up, 'w_ffn1_down': w_ffn1_down,
        'g_mix': g_mix, 'w_in': w_in, 'w_gate_up': w_gate_up, 'b_gate': b_gate,
        'g_gla_head': g_gla_head, 'w_gla_out': w_gla_out,
        's5_lam_re': s5_lam_re, 's5_lam_im': s5_lam_im, 's5_log_dt': s5_log_dt,
        's5_b_re': s5_b_re, 's5_b_im': s5_b_im, 's5_c_re': s5_c_re, 's5_c_im': s5_c_im, 's5_d': s5_d,
        'w_glu_a': w_glu_a, 'w_glu_b': w_glu_b, 'w_s5_out': w_s5_out, 'w_out': w_out,
        'g_ffn2': g_ffn2, 'w_ffn2_gate': w_ffn2_gate, 'w_ffn2_up': w_ffn2_up, 'w_ffn2_down': w_ffn2_down,
    }
    bp = x_prompt.shape[0]
    hp, gla_p, s5_p = x_prompt, jnp.zeros((bp, GLA_HEADS, GLA_DK, GLA_DV), jnp.float32), jnp.zeros((bp, S5_GROUPS, S5_STATE, 2), jnp.float32)
    hs, gla_s, s5_s = x_sample, state_gla, state_s5
    for _ in range(DEPTH):
        hp, gla_p, s5_p = _layer(hp, gla_p, s5_p, CHUNK, p)
        hs, gla_s, s5_s = _layer(hs, gla_s, s5_s, x_sample.shape[1], p)
    y_prompt = _rmsnorm(hp, g_final)
    y_sample = _rmsnorm(hs, g_final)
    return (y_prompt, y_sample, gla_p, s5_p, gla_s, s5_s)
```

```cpp
#include <hip/hip_runtime.h>
#include <hip/hip_cooperative_groups.h>
#include <cstdio>
#include <cstdint>
namespace cg = cooperative_groups;


#define LAS __attribute__((address_space(3)))
typedef unsigned short bf16_t;
typedef short bf16x8 __attribute__((ext_vector_type(8)));
typedef float f32x4 __attribute__((ext_vector_type(4)));
typedef float f32x2 __attribute__((ext_vector_type(2)));
typedef unsigned u32x4 __attribute__((ext_vector_type(4)));
typedef unsigned u32x2 __attribute__((ext_vector_type(2)));

constexpr int MP = 32768;
constexpr int MS = 1024;
constexpr int M = MP + MS;
constexpr int D = 1024, FF = 2816;
constexpr int NZ = 4352;
constexpr int LDZ = 4096;
constexpr int ZQ = 0, ZK = 256, ZV = 512, ZR = 1024, ZU = 1536, ZGG = 2048, ZG5 = 3072;
constexpr int NCH = 528;
constexpr float EPS = 1e-6f;

constexpr size_t SZ_WGU = (size_t)5632 * 1024 * 2, SZ_WD = (size_t)1024 * 2816 * 2, SZ_WIN = (size_t)NZ * 1024 * 2;
constexpr size_t SZ_W512 = (size_t)1024 * 512 * 2, SZ_WOUT = (size_t)1024 * 1024 * 2;
constexpr size_t WS_WGU1 = 0;
constexpr size_t WS_WD1 = WS_WGU1 + SZ_WGU;
constexpr size_t WS_WIN = WS_WD1 + SZ_WD;
constexpr size_t WS_WGLU = WS_WIN + SZ_WIN;
constexpr size_t WS_WGO = WS_WGLU + SZ_W512;
constexpr size_t WS_WS5O = WS_WGO + SZ_W512;
constexpr size_t WS_WOUT = WS_WS5O + SZ_W512;
constexpr size_t WS_WGU2 = WS_WOUT + SZ_WOUT;
constexpr size_t WS_WD2 = WS_WGU2 + SZ_WGU;
constexpr size_t WS_RB = WS_WD2 + SZ_WD;
constexpr size_t SZ_RB = (size_t)M * 1024 * 2;
constexpr size_t WS_Z = WS_RB + SZ_RB;
constexpr size_t SZ_Z = (size_t)M * LDZ * 2;
constexpr size_t WS_LA = WS_Z + SZ_Z;
constexpr size_t SZ_LA = (size_t)M * 256 * 4;
constexpr size_t WS_R2 = WS_LA + SZ_LA;
constexpr size_t WS_SPB = WS_R2 + (size_t)NCH * 4 * 8192 * 2;
constexpr size_t SZ_R2 = (size_t)M * 1024 * 2;
constexpr size_t WS_SSX = WS_R2 + SZ_R2;
constexpr size_t WS_SSH = WS_SSX + (size_t)M * 4;
constexpr size_t WS_SS2 = WS_SSH + (size_t)M * 64;
constexpr size_t WS_SS3 = WS_SS2 + (size_t)M * 64;
constexpr size_t WS_DEC = WS_SS3 + (size_t)M * 64;
constexpr size_t WS_E = WS_DEC + (size_t)NCH * 4 * 64 * 4;
constexpr size_t WS_TBL = WS_E + (size_t)512 * 32 * 64 * 2 * 4;
constexpr size_t T_ABAR = 0, T_ABAR64 = 16384, T_BB = 32768, T_CC = T_BB + 262144, TBL_STRIDE = T_CC + 131072;
constexpr size_t WS_CC_END = WS_TBL + 16 * TBL_STRIDE;
constexpr size_t WS_XP = WS_CC_END;
constexpr size_t WS_CTL = WS_XP + (size_t)512 * 32 * 64 * 2 * 4;
constexpr size_t WS_END = WS_CTL + 8192;

constexpr size_t O_Y = 0, O_GLAP = (size_t)M * 1024, O_S5P = O_GLAP + 65536, O_GLAS = O_S5P + 8192, O_S5S = O_GLAS + 524288;

constexpr int LDS_BYTES = 147456;
constexpr int N_PHASES = 13;
constexpr int S5_NW = 4;

struct Params {
    const float* in[31];
    float* out;
    unsigned char* ws;
    int ph_lo, ph_hi;
};

__device__ __forceinline__ unsigned cvt_pk_bf16(float lo, float hi) { unsigned r; asm volatile("v_cvt_pk_bf16_f32 %0, %1, %2" : "=v"(r) : "v"(lo), "v"(hi)); return r; }
__device__ __forceinline__ bf16_t f2bf(float f) { return (bf16_t)(cvt_pk_bf16(f, 0.f) & 0xffffu); }
__device__ __forceinline__ float bf2f(bf16_t b) { return __uint_as_float(((unsigned)b) << 16); }
__device__ __forceinline__ float bflo(unsigned w) { return __uint_as_float(w << 16); }
__device__ __forceinline__ float bfhi(unsigned w) { return __uint_as_float(w & 0xffff0000u); }
__device__ __forceinline__ float fsigmoid(float x) { return __builtin_amdgcn_rcpf(1.0f + __expf(-x)); }
__device__ __forceinline__ float fsilu(float x) { return x * fsigmoid(x); }
__device__ __forceinline__ float wave_sum(float v) {
#pragma unroll
    for (int o = 1; o < 64; o <<= 1) v += __shfl_xor(v, o);
    return v;
}
__device__ __forceinline__ float row_rstd(const float* ss, int np, int row) {
    float s;
    if (np == 1) s = ss[row];
    else { const f32x4* p = (const f32x4*)(ss + (size_t)row * 16); f32x4 a = p[0], b = p[1], c = p[2], d = p[3];
        s = ((a.x + a.y) + (a.z + a.w)) + ((b.x + b.y) + (b.z + b.w)) + ((c.x + c.y) + (c.z + c.w)) + ((d.x + d.y) + (d.z + d.w)); }
    return rsqrtf(s * (1.0f / 1024.0f) + EPS);
}
#define RLX_AGENT __ATOMIC_RELAXED, __HIP_MEMORY_SCOPE_AGENT
#define LDS_FENCE() asm volatile("s_waitcnt lgkmcnt(0)" ::: "memory")
__device__ __forceinline__ f32x4 mfma_safe(bf16x8 a, bf16x8 b, f32x4 acc) {
    asm volatile("s_nop 1\n\tv_mfma_f32_16x16x32_bf16 %0, %1, %2, %0\n\ts_nop 7\n\ts_nop 7" : "+v"(acc) : "v"(a), "v"(b));
    return acc;
}


namespace pg8 {
constexpr int BM = 256, BK = 64, HALF = 128, HTB = HALF * BK * 2, STAGE_BYTES = 8 * HTB, NXCD = 8, WGM = 8;
__host__ __device__ __forceinline__ int lds_byte(int r, int c) { const int st = (r >> 4) * 2 + (c >> 5), rr = r & 15, cc = c & 31, ob = rr * 64 + cc * 2; return st * 1024 + (ob ^ (((ob >> 9) & 1) << 5)); }
__host__ __device__ __forceinline__ void stage_rc(int b, int& R, int& C) { const int st = b / 1024, sb = b % 1024, swz = sb ^ (((sb >> 9) & 1) << 5); R = (st >> 1) * 16 + swz / 64; C = (st & 1) * 32 + (swz % 64) / 2; }
__host__ __device__ __forceinline__ int perm32(int rho) { const int n = rho >> 4, i = rho & 15; return 8 * (i >> 2) + 4 * n + (i & 3); }
struct Unit { int pm, pn; };
struct Gemm { const bf16_t* A; const bf16_t* Bt; int M, N, K; };
struct StaticOrder {
    int nM, nN, nwg, G, c;
    __host__ __device__ void init(int M_, int N_, int G_, int c_) { nM = M_ / BM; nN = N_ / BM; nwg = nM * nN; G = G_; c = c_; }
    __host__ __device__ bool next(int i, Unit& u) const {
        const long L = (long)i * G + c; if (L >= nwg) return false;
        int wgid = (int)L; { const int q = nwg / NXCD, r = nwg % NXCD, xcd = wgid % NXCD, off = wgid / NXCD; wgid = (xcd < r ? xcd * (q + 1) : r * (q + 1) + (xcd - r) * q) + off; }
        const int nig = WGM * nN, gid = wgid / nig, fm = gid * WGM, gsz = (nM - fm) < WGM ? (nM - fm) : WGM;
        u.pm = fm + ((wgid % nig) % gsz); u.pn = (wgid % nig) / gsz; return true;
    }
};

struct XMap { int nx, xi, rank, nb; };
__device__ __forceinline__ int xm_ntiles(const XMap& x, int nM) { return (nM - x.xi + x.nx - 1) / x.nx; }
struct XcdOrder {
    int nN, nt, nu, rank, nb, xi, nx;
    __device__ void init(int M_, int N_, const XMap& x) { nN = N_ / BM; nt = xm_ntiles(x, M_ / BM); nu = nt * nN; rank = x.rank; nb = x.nb; xi = x.xi; nx = x.nx; }
    __device__ bool next(int i, Unit& u) const {
        const int L = i * nb + rank; if (L >= nu) return false;
        const int per = 4 * nN, g = L / per, l = L % per, gsz = (nt - 4 * g) < 4 ? (nt - 4 * g) : 4;
        u.pm = xi + (4 * g + l % gsz) * nx; u.pn = l / gsz; return true;
    }
};

template <class Epi, class Sched>
__device__ __forceinline__ void gemm_phase(LAS unsigned char* lds, const Gemm g, const Sched& S, const Epi& E) {
    const int tid = threadIdx.x, wid = __builtin_amdgcn_readfirstlane(tid >> 6), lane = tid & 63, wr = wid >> 2, wc = wid & 3, fr = lane & 15, fq = lane >> 4;
    const int K = g.K, nt = K / BK;
    unsigned voffA[2], voffB[2];
#pragma unroll
    for (int i = 0; i < 2; ++i) { int R, C; stage_rc(tid * 16 + i * 8192, R, C); const int Rb = Epi::PERM ? ((R & ~31) + perm32(R & 31)) : R;
        voffA[i] = (unsigned)(R * K + C) * 2u; voffB[i] = (unsigned)(Rb * K + C) * 2u; }
    const size_t kstep = (size_t)(BK * 2);
    const size_t hstep = (size_t)HALF * K * 2;
    const size_t tstep = 2 * hstep;
    const unsigned ldsw = (unsigned)wid * 1024u;
    const int aoff = lds_byte(wr * 64 + fr, fq * 8), boff = lds_byte(wc * 32 + fr, fq * 8);
#define PG8_SA(b, h) (((b) * 2 + (h)) * HTB)
#define PG8_SB(b, h) ((4 + (b) * 2 + (h)) * HTB)
#define PG8_STAGE(bufoff, gbase, voff) do { _Pragma("unroll") for (int _i = 0; _i < 2; ++_i) \
        __builtin_amdgcn_global_load_lds((const unsigned*)((const char*)(gbase) + (voff)[_i]), (LAS unsigned*)(lds + (bufoff) + ldsw + _i * 8192), 16, 0, 0); } while (0)
#define PG8_LDA(dst, b, h) do { _Pragma("unroll") for (int m = 0; m < 4; ++m) _Pragma("unroll") for (int k = 0; k < 2; ++k) dst[m][k] = *(const LAS bf16x8*)(lds + PG8_SA(b, h) + aoff + m * 2048 + k * 1024); } while (0)
#define PG8_LDB(dst, b, h) do { _Pragma("unroll") for (int n = 0; n < 2; ++n) _Pragma("unroll") for (int k = 0; k < 2; ++k) dst[n][k] = *(const LAS bf16x8*)(lds + PG8_SB(b, h) + boff + n * 2048 + k * 1024); } while (0)
#define PG8_MMA(ai, bj, At, Bt) do { __builtin_amdgcn_s_setprio(1); _Pragma("unroll") for (int m = 0; m < 4; ++m) _Pragma("unroll") for (int n = 0; n < 2; ++n) _Pragma("unroll") for (int k = 0; k < 2; ++k) \
        acc[ai][bj][m][n] = __builtin_amdgcn_mfma_f32_16x16x32_bf16(Bt[n][k], At[m][k], acc[ai][bj][m][n], 0, 0, 0); __builtin_amdgcn_s_setprio(0); } while (0)
#define PG8_WAIT_V(n) asm volatile("s_waitcnt vmcnt(" #n ")" ::: "memory")
#define PG8_WAIT_L(n) asm volatile("s_waitcnt lgkmcnt(" #n ")" ::: "memory")
#define PG8_BAR __builtin_amdgcn_s_barrier()
#define PG8_SCHED __builtin_amdgcn_sched_barrier(0)
    Unit cur, nxt; int ui = 0;
    if (!S.next(0, cur)) return;
    f32x4 acc[2][2][4][2];
#pragma unroll
    for (int a = 0; a < 2; ++a)
#pragma unroll
        for (int b = 0; b < 2; ++b)
#pragma unroll
            for (int m = 0; m < 4; ++m)
#pragma unroll
                for (int n = 0; n < 2; ++n) acc[a][b][m][n] = (f32x4){0.f, 0.f, 0.f, 0.f};
    bf16x8 At[4][2], B0[2][2], B1[2][2];
    const char* cA = (const char*)g.A + (size_t)cur.pm * tstep; const char* cB = (const char*)g.Bt + (size_t)cur.pn * tstep;
    PG8_STAGE(PG8_SB(0, 0), cB, voffB); PG8_STAGE(PG8_SA(0, 0), cA, voffA); PG8_STAGE(PG8_SB(0, 1), cB + hstep, voffB); PG8_STAGE(PG8_SA(0, 1), cA + hstep, voffA);
    if (wr == 1) PG8_BAR;
    PG8_WAIT_V(4); PG8_BAR;
    PG8_STAGE(PG8_SB(1, 0), cB + kstep, voffB); PG8_STAGE(PG8_SA(1, 0), cA + kstep, voffA); PG8_STAGE(PG8_SB(1, 1), cB + hstep + kstep, voffB);
    PG8_WAIT_V(6); PG8_BAR;
    for (;;) {
        const bool has_next = S.next(ui + 1, nxt);
        const char* nA = has_next ? (const char*)g.A + (size_t)nxt.pm * tstep : cA; const char* nB = has_next ? (const char*)g.Bt + (size_t)nxt.pn * tstep : cB;
        for (int t = 0; t < nt; t += 2) {
            const bool last = (t == nt - 2);
            const char* a1 = cA + (size_t)(t + 1) * kstep;
            const char* a2 = last ? nA : cA + (size_t)(t + 2) * kstep; const char* b2 = last ? nB : cB + (size_t)(t + 2) * kstep;
            const char* a3 = a2 + kstep; const char* b3 = b2 + kstep;
            PG8_LDB(B0, 0, 0); PG8_SCHED; PG8_LDA(At, 0, 0); PG8_STAGE(PG8_SA(1, 1), a1 + hstep, voffA);
            PG8_WAIT_L(8); PG8_BAR; PG8_WAIT_L(0); PG8_MMA(0, 0, At, B0); PG8_BAR; PG8_SCHED;
            PG8_LDB(B1, 0, 1); PG8_STAGE(PG8_SB(0, 0), b2, voffB);
            PG8_BAR; PG8_WAIT_L(0); PG8_MMA(0, 1, At, B1); PG8_BAR;
            PG8_LDA(At, 0, 1); PG8_STAGE(PG8_SA(0, 0), a2, voffA);
            PG8_BAR; PG8_WAIT_L(0); PG8_MMA(1, 0, At, B0); PG8_BAR; PG8_SCHED;
            PG8_STAGE(PG8_SB(0, 1), b2 + hstep, voffB);
            PG8_WAIT_V(6); PG8_BAR; PG8_MMA(1, 1, At, B1); PG8_BAR;
            PG8_LDB(B0, 1, 0); PG8_SCHED; PG8_LDA(At, 1, 0); PG8_STAGE(PG8_SA(0, 1), a2 + hstep, voffA);
            PG8_WAIT_L(8); PG8_BAR; PG8_WAIT_L(0); PG8_MMA(0, 0, At, B0); PG8_BAR; PG8_SCHED;
            PG8_LDB(B1, 1, 1); PG8_STAGE(PG8_SB(1, 0), b3, voffB);
            PG8_BAR; PG8_WAIT_L(0); PG8_MMA(0, 1, At, B1); PG8_BAR;
            PG8_LDA(At, 1, 1); PG8_STAGE(PG8_SA(1, 0), a3, voffA);
            PG8_BAR; PG8_WAIT_L(0); PG8_MMA(1, 0, At, B0); PG8_BAR; PG8_SCHED;
            PG8_STAGE(PG8_SB(1, 1), b3 + hstep, voffB);
            PG8_WAIT_V(6); PG8_BAR; PG8_MMA(1, 1, At, B1); PG8_BAR;
        }
        E(acc, cur, wr, wc, fr, fq);
        if (!has_next) break;
#pragma unroll
        for (int a = 0; a < 2; ++a)
#pragma unroll
            for (int b = 0; b < 2; ++b)
#pragma unroll
                for (int m = 0; m < 4; ++m)
#pragma unroll
                    for (int n = 0; n < 2; ++n) acc[a][b][m][n] = (f32x4){0.f, 0.f, 0.f, 0.f};
        cur = nxt; cA = nA; cB = nB; ++ui;
    }
    PG8_WAIT_V(0);
    if (wr == 0) PG8_BAR;
    PG8_BAR;
#undef PG8_SA
#undef PG8_SB
#undef PG8_STAGE
#undef PG8_LDA
#undef PG8_LDB
#undef PG8_MMA
#undef PG8_WAIT_V
#undef PG8_WAIT_L
#undef PG8_BAR
#undef PG8_SCHED
}
}
using pg8::Unit;

typedef f32x4 AccT[2][2][4][2];

template <bool GLU> struct EpiGated {
    static constexpr bool PERM = true;
    bf16_t* O; int ldc; const float* ss; int np;
    __device__ __forceinline__ void operator()(const AccT& acc, const Unit& u, int wr, int wc, int fr, int fq) const {
        const int row0 = u.pm * 256 + wr * 64 + fr, col0 = u.pn * 128 + wc * 32 + 8 * fq;
#pragma unroll
        for (int ai = 0; ai < 2; ++ai)
#pragma unroll
            for (int m = 0; m < 4; ++m) {
                const int row = row0 + ai * 128 + m * 16;
                float o[8];
                if (GLU) {
#pragma unroll
                    for (int n = 0; n < 2; ++n)
#pragma unroll
                        for (int j = 0; j < 4; ++j) o[n * 4 + j] = acc[ai][0][m][n][j] * fsigmoid(acc[ai][1][m][n][j]);
                } else {
                    const float rs = row_rstd(ss, np, row);
#pragma unroll
                    for (int n = 0; n < 2; ++n)
#pragma unroll
                        for (int j = 0; j < 4; ++j) o[n * 4 + j] = fsilu(acc[ai][0][m][n][j] * rs) * (acc[ai][1][m][n][j] * rs);
                }
                u32x4 w; w.x = cvt_pk_bf16(o[0], o[1]); w.y = cvt_pk_bf16(o[2], o[3]); w.z = cvt_pk_bf16(o[4], o[5]); w.w = cvt_pk_bf16(o[6], o[7]);
                *(u32x4*)(O + (size_t)row * ldc + col0) = w;
            }
    }
};

struct EpiRes {
    static constexpr bool PERM = false;
    const float* res0; const float* res1; float* out; bf16_t* outb; float* ssout; float scale;
    __device__ __forceinline__ void operator()(const AccT& acc, const Unit& u, int wr, int wc, int fr, int fq) const {
        const int row0 = u.pm * 256 + wr * 64 + fr, col0 = u.pn * 256 + wc * 32 + 4 * fq;
#pragma unroll
        for (int ai = 0; ai < 2; ++ai)
#pragma unroll
            for (int m = 0; m < 4; ++m) {
                const int row = row0 + ai * 128 + m * 16;
                const float* rp = (row < MP ? res0 + (size_t)row * 1024 : res1 + (size_t)(row - MP) * 1024) + col0;
                float* op = out + (size_t)row * 1024 + col0;
                float ssq = 0.f;
#pragma unroll
                for (int bj = 0; bj < 2; ++bj)
#pragma unroll
                    for (int n = 0; n < 2; ++n) {
                        const f32x4 r4 = *(const f32x4*)(rp + bj * 128 + n * 16);
                        const f32x4 v = r4 + acc[ai][bj][m][n] * scale;
                        *(f32x4*)(op + bj * 128 + n * 16) = v;
                        ssq += (v.x * v.x + v.y * v.y) + (v.z * v.z + v.w * v.w);
                        if (outb) { u32x2 w; w.x = cvt_pk_bf16(v.x, v.y); w.y = cvt_pk_bf16(v.z, v.w); *(u32x2*)(outb + (size_t)row * 1024 + col0 + bj * 128 + n * 16) = w; }
                    }
                ssq += __shfl_xor(ssq, 16); ssq += __shfl_xor(ssq, 32);
                if (fq == 0) ssout[(size_t)row * 16 + u.pn * 4 + wc] = ssq;
            }
    }
};

struct EpiZ {
    static constexpr bool PERM = true;
    bf16_t* Z; float* LA; const float* ss; const float* bgate;
    __device__ __forceinline__ void operator()(const AccT& acc, const Unit& u, int wr, int wc, int fr, int fq) const {
        const int row0 = u.pm * 256 + wr * 64 + fr, cw = wc * 32 + 8 * fq;
        const int pn = u.pn;
        const int zc0 = (pn < 6 ? pn : pn - 1) * 256;
        const int mode = (pn == 6) ? 3 : ((pn == 4 || pn == 5) ? 1 : (pn >= 9 ? 2 : 0));
#pragma unroll
        for (int ai = 0; ai < 2; ++ai)
#pragma unroll
            for (int m = 0; m < 4; ++m) {
                const int row = row0 + ai * 128 + m * 16;
                const float rs = row_rstd(ss, 16, row);
#pragma unroll
                for (int bj = 0; bj < 2; ++bj) {
                    float o[8];
#pragma unroll
                    for (int n = 0; n < 2; ++n)
#pragma unroll
                        for (int j = 0; j < 4; ++j) o[n * 4 + j] = acc[ai][bj][m][n][j] * rs;
                    const int c = bj * 128 + cw;
                    if (mode == 3) {
                        const f32x4 b0 = *(const f32x4*)(bgate + c), b1 = *(const f32x4*)(bgate + c + 4);
                        const float bb[8] = {b0.x, b0.y, b0.z, b0.w, b1.x, b1.y, b1.z, b1.w};
#pragma unroll
                        for (int i = 0; i < 8; ++i) { const float x = o[i] + bb[i]; o[i] = (fminf(x, 0.f) - __logf(1.0f + __expf(-fabsf(x)))) * (1.0f / 16.0f); }
                        float* lp = LA + (size_t)row * 256 + c;
                        *(f32x4*)lp = (f32x4){o[0], o[1], o[2], o[3]}; *(f32x4*)(lp + 4) = (f32x4){o[4], o[5], o[6], o[7]};
                    } else {
                        if (mode == 1) {
#pragma unroll
                            for (int i = 0; i < 8; ++i) o[i] = fsilu(o[i]);
                        } else if (mode == 2) {
#pragma unroll
                            for (int i = 0; i < 8; ++i) o[i] = fsigmoid(o[i]);
                        }
                        u32x4 w; w.x = cvt_pk_bf16(o[0], o[1]); w.y = cvt_pk_bf16(o[2], o[3]); w.z = cvt_pk_bf16(o[4], o[5]); w.w = cvt_pk_bf16(o[6], o[7]);
                        *(u32x4*)(Z + (size_t)row * LDZ + zc0 + c) = w;
                    }
                }
            }
    }
};

template <bool ADD> struct EpiMix {
    static constexpr bool PERM = true;
    bf16_t* T; const bf16_t* Z; int zoff;
    __device__ __forceinline__ void operator()(const AccT& acc, const Unit& u, int wr, int wc, int fr, int fq) const {
        const int row0 = u.pm * 256 + wr * 64 + fr, col0 = u.pn * 256 + wc * 32 + 8 * fq;
#pragma unroll
        for (int ai = 0; ai < 2; ++ai)
#pragma unroll
            for (int m = 0; m < 4; ++m) {
                const int row = row0 + ai * 128 + m * 16;
#pragma unroll
                for (int bj = 0; bj < 2; ++bj) {
                    const int col = col0 + bj * 128;
                    const u32x4 gw = *(const u32x4*)(Z + (size_t)row * LDZ + zoff + col);
                    float o[8];
                    o[0] = bflo(gw.x) * acc[ai][bj][m][0][0]; o[1] = bfhi(gw.x) * acc[ai][bj][m][0][1];
                    o[2] = bflo(gw.y) * acc[ai][bj][m][0][2]; o[3] = bfhi(gw.y) * acc[ai][bj][m][0][3];
                    o[4] = bflo(gw.z) * acc[ai][bj][m][1][0]; o[5] = bfhi(gw.z) * acc[ai][bj][m][1][1];
                    o[6] = bflo(gw.w) * acc[ai][bj][m][1][2]; o[7] = bfhi(gw.w) * acc[ai][bj][m][1][3];
                    bf16_t* tp = T + (size_t)row * 1024 + col;
                    if (ADD) { const u32x4 tw = *(const u32x4*)tp;
                        o[0] += bflo(tw.x); o[1] += bfhi(tw.x); o[2] += bflo(tw.y); o[3] += bfhi(tw.y);
                        o[4] += bflo(tw.z); o[5] += bfhi(tw.z); o[6] += bflo(tw.w); o[7] += bfhi(tw.w); }
                    u32x4 w; w.x = cvt_pk_bf16(o[0], o[1]); w.y = cvt_pk_bf16(o[2], o[3]); w.z = cvt_pk_bf16(o[4], o[5]); w.w = cvt_pk_bf16(o[6], o[7]);
                    *(u32x4*)tp = w;
                }
            }
    }
};

__device__ __forceinline__ void tr_item(const float* W, int ldw, int scol, int k0, const float* gain, bf16_t* WT, int ldt, int n_dst0, LAS float* scr, int lane) {
#pragma unroll 8
    for (int i = 0; i < 32; ++i) { const int kk = 2 * i + (lane >> 5); float v = W[(size_t)(k0 + kk) * ldw + scol + (lane & 31)]; if (gain) v *= gain[k0 + kk]; scr[kk * 33 + (lane & 31)] = v; }
    LDS_FENCE();
    const int c = lane & 7;
#pragma unroll
    for (int j = 0; j < 4; ++j) { const int n = (lane >> 3) + 8 * j; const LAS float* s = scr + (8 * c) * 33 + n;
        u32x4 o; o.x = cvt_pk_bf16(s[0 * 33], s[1 * 33]); o.y = cvt_pk_bf16(s[2 * 33], s[3 * 33]); o.z = cvt_pk_bf16(s[4 * 33], s[5 * 33]); o.w = cvt_pk_bf16(s[6 * 33], s[7 * 33]);
        *(u32x4*)(WT + (size_t)(n_dst0 + n) * ldt + k0 + 8 * c) = o; }
    LDS_FENCE();
}

__device__ __forceinline__ void p0_phase(const Params& P, LAS unsigned char* lds, const pg8::XMap& xm) {
    const int tid = threadIdx.x, lane = tid & 63, wave = tid >> 6;
    const int gw = blockIdx.x * 8 + wave, NGW = gridDim.x * 8;
    unsigned char* ws = P.ws;
    LAS float* scr = (LAS float*)lds + wave * (64 * 33);
    constexpr int I_GU = 16 * 176, I_D = 44 * 32, I_IN = 16 * 136, I_512 = 8 * 32, I_OUT = 16 * 32;
    constexpr int NIT = 2 * I_GU + 2 * I_D + I_IN + 3 * I_512 + I_OUT;
    if (wave < 7) for (int it = blockIdx.x * 7 + wave; it < NIT; it += gridDim.x * 7) {
        int r = it;
        if (r < 2 * I_GU) {
            const int l = r >= I_GU; r -= l * I_GU;
            const int kb = r / 176, nb = r % 176, n0 = nb * 32, pn = n0 >> 8, bj = (n0 >> 7) & 1, c = n0 & 127;
            const float* src = l ? (bj ? P.in[28] : P.in[27]) : (bj ? P.in[6] : P.in[5]);
            tr_item(src, FF, pn * 128 + c, kb * 64, l ? P.in[26] : P.in[4], (bf16_t*)(ws + (l ? WS_WGU2 : WS_WGU1)), 1024, n0, scr, lane);
            continue;
        }
        r -= 2 * I_GU;
        if (r < 2 * I_D) {
            const int l = r >= I_D; r -= l * I_D;
            const int kb = r / 32, nb = r % 32;
            tr_item(l ? P.in[29] : P.in[7], 1024, nb * 32, kb * 64, nullptr, (bf16_t*)(ws + (l ? WS_WD2 : WS_WD1)), FF, nb * 32, scr, lane);
            continue;
        }
        r -= 2 * I_D;
        if (r < I_IN) {
            const int kb = r / 136, nb = r % 136, n0 = nb * 32, k0 = kb * 64;
            bf16_t* WT = (bf16_t*)(ws + WS_WIN);
            if (n0 >= 1536 && n0 < 1792) {
                const int k = k0 + lane; const float gk = P.in[8][k];
                float a[16];
#pragma unroll
                for (int i = 0; i < 16; ++i) a[i] = gk * P.in[9][(size_t)k * 4112 + 1536 + i];
                const int j0 = n0 - 1536;
                for (int j = 0; j < 32; ++j) { float s = 0.f;
#pragma unroll
                    for (int i = 0; i < 16; ++i) s += a[i] * P.in[10][i * 256 + j0 + j];
                    WT[(size_t)(n0 + j) * 1024 + k] = f2bf(s); }
            } else {
                tr_item(P.in[9], 4112, n0 < 1536 ? n0 : n0 - 240, k0, P.in[8], WT, 1024, n0, scr, lane);
            }
            continue;
        }
        r -= I_IN;
        if (r < I_512) {
            const int kb = r / 32, nb = r % 32, n0 = nb * 32, pn = n0 >> 8, bj = (n0 >> 7) & 1, c = n0 & 127;
            tr_item(bj ? P.in[23] : P.in[22], 512, pn * 128 + c, kb * 64, nullptr, (bf16_t*)(ws + WS_WGLU), 512, n0, scr, lane);
            continue;
        }
        r -= I_512;
        if (r < 2 * I_512) {
            const int l = r >= I_512; r -= l * I_512;
            const int kb = r / 32, nb = r % 32;
            tr_item(l ? P.in[24] : P.in[13], 1024, nb * 32, kb * 64, nullptr, (bf16_t*)(ws + (l ? WS_WS5O : WS_WGO)), 512, nb * 32, scr, lane);
            continue;
        }
        r -= 2 * I_512;
        { const int kb = r / 32, nb = r % 32;
          tr_item(P.in[25], 1024, nb * 32, kb * 64, nullptr, (bf16_t*)(ws + WS_WOUT), 1024, nb * 32, scr, lane); }
    }
    bf16_t* XB = (bf16_t*)(ws + WS_RB); float* SSX = (float*)(ws + WS_SSX);
    for (int u = xm.rank * 8 + wave; u < pg8::xm_ntiles(xm, M / 256) * 256; u += xm.nb * 8) {
        const int row = (xm.xi + (u >> 8) * xm.nx) * 256 + (u & 255);
        const float* xr = row < MP ? P.in[0] + (size_t)row * 1024 : P.in[1] + (size_t)(row - MP) * 1024;
        f32x4 v[4]; float s = 0.f;
#pragma unroll
        for (int j = 0; j < 4; ++j) { v[j] = ((const f32x4*)xr)[lane + 64 * j]; s += (v[j].x * v[j].x + v[j].y * v[j].y) + (v[j].z * v[j].z + v[j].w * v[j].w); }
        s = wave_sum(s);
        if (lane == 0) SSX[row] = s;
#pragma unroll
        for (int j = 0; j < 4; ++j) { u32x2 w; w.x = cvt_pk_bf16(v[j].x, v[j].y); w.y = cvt_pk_bf16(v[j].z, v[j].w); ((u32x2*)(XB + (size_t)row * 1024))[lane + 64 * j] = w; }
    }
    const int gp = xm.rank * 512 + tid;
    unsigned char* tb = ws + WS_TBL + (size_t)xm.xi * TBL_STRIDE;
    for (int gp0 = gp; gp0 < 2048; gp0 += xm.nb * 512) { const int gp = gp0;
        const int g = gp >> 6, p = gp & 63;
        const float lr = P.in[14][gp], li = P.in[15][gp], dt = expf(P.in[16][g]);
        const float mag = expf(lr * dt); float ar = mag * cosf(li * dt), ai = mag * sinf(li * dt);
        const float nr = ar - 1.0f, ni = ai, den = lr * lr + li * li;
        const float fre = (nr * lr + ni * li) / den, fim = (ni * lr - nr * li) / den;
        bf16_t* BB = (bf16_t*)(tb + T_BB); bf16_t* CC = (bf16_t*)(tb + T_CC);
        for (int h = 0; h < 16; ++h) { const float br = P.in[17][gp * 16 + h], bi = P.in[18][gp * 16 + h];
            BB[(g * 128 + p) * 32 + h] = f2bf(fre * br - fim * bi); BB[(g * 128 + 64 + p) * 32 + h] = f2bf(fre * bi + fim * br);
            BB[(g * 128 + p) * 32 + 16 + h] = 0; BB[(g * 128 + 64 + p) * 32 + 16 + h] = 0; }
        for (int j = 0; j < 16; ++j) { CC[(g * 16 + j) * 128 + p] = f2bf(P.in[19][(g * 16 + j) * 64 + p]); CC[(g * 16 + j) * 128 + 64 + p] = f2bf(-P.in[20][(g * 16 + j) * 64 + p]); }
        float* AB = (float*)(tb + T_ABAR); AB[gp * 2] = ar; AB[gp * 2 + 1] = ai;
#pragma unroll
        for (int i = 0; i < 6; ++i) { const float t = ar * ar - ai * ai; ai = 2.0f * ar * ai; ar = t; }
        float* AB64 = (float*)(tb + T_ABAR64); AB64[gp * 2] = ar; AB64[gp * 2 + 1] = ai;
    }
}

__device__ __forceinline__ void gla_cumsum(const float* LA, int row0, int h, int w, int lane, LAS float* tot, float (&b)[8], float& blast) {
    float run = 0.f;
#pragma unroll
    for (int i = 0; i < 8; ++i) { run += LA[(size_t)(row0 + 8 * w + i) * 256 + h * 64 + lane]; b[i] = run; }
    tot[w * 64 + lane] = run;
    __syncthreads();
    float off = 0.f, all = 0.f;
#pragma unroll
    for (int ww = 0; ww < 8; ++ww) { const float tv = tot[ww * 64 + lane]; all += tv; if (ww < w) off += tv; }
#pragma unroll
    for (int i = 0; i < 8; ++i) b[i] += off;
    blast = all;
}

constexpr int LP = 72;
constexpr int L_QS = 0, L_KS = L_QS + 64 * LP * 2, L_VT = L_KS + 64 * LP * 2, L_ST = L_VT + 128 * LP * 2, L_PS = L_ST + 128 * LP * 2, L_TOT = L_PS  , L_SSQ = L_KS  , L_GLA_END = L_PS + 64 * LP * 2;
static_assert(L_GLA_END <= 65536, "GLA LDS must stay below 64 KiB");

__device__ __forceinline__ void gla_local(const Params& P, LAS unsigned char* lds, int c, int h) {
    const int tid = threadIdx.x, lane = tid & 63, w = tid >> 6, r = lane & 15, q = lane >> 4;
    unsigned char* ws = P.ws;
    const bf16_t* Z = (const bf16_t*)(ws + WS_Z); const float* LA = (const float*)(ws + WS_LA);
    LAS bf16_t* Kt = (LAS bf16_t*)(lds + L_KS); LAS bf16_t* Vt = (LAS bf16_t*)(lds + L_VT); LAS float* tot = (LAS float*)(lds + L_TOT);
    const int row0 = c * 64;
    float b[8], blast;
    gla_cumsum(LA, row0, h, w, lane, tot, b, blast);
    { float kh[8];
#pragma unroll
      for (int i = 0; i < 8; ++i) kh[i] = bf2f(Z[(size_t)(row0 + 8 * w + i) * LDZ + ZK + h * 64 + lane]) * __expf(blast - b[i]);
      u32x4 o; o.x = cvt_pk_bf16(kh[0], kh[1]); o.y = cvt_pk_bf16(kh[2], kh[3]); o.z = cvt_pk_bf16(kh[4], kh[5]); o.w = cvt_pk_bf16(kh[6], kh[7]);
      *(LAS u32x4*)(Kt + lane * LP + 8 * w) = o; }
#pragma unroll
    for (int half = 0; half < 2; ++half) { unsigned vv[8];
#pragma unroll
        for (int i = 0; i < 8; ++i) vv[i] = Z[(size_t)(row0 + 8 * w + i) * LDZ + ZV + h * 128 + half * 64 + lane];
        u32x4 o; o.x = vv[0] | (vv[1] << 16); o.y = vv[2] | (vv[3] << 16); o.z = vv[4] | (vv[5] << 16); o.w = vv[6] | (vv[7] << 16);
        *(LAS u32x4*)(Vt + (half * 64 + lane) * LP + 8 * w) = o; }
    if (w == 7) ((float*)(ws + WS_DEC))[(c * 4 + h) * 64 + lane] = __expf(blast);
    __syncthreads();
    bf16_t* DS = (bf16_t*)(ws + WS_R2) + (size_t)(c * 4 + h) * 8192;
    const int dkt = w & 3;
    bf16x8 a0 = *(const LAS bf16x8*)(Kt + (dkt * 16 + r) * LP + 8 * q), a1 = *(const LAS bf16x8*)(Kt + (dkt * 16 + r) * LP + 32 + 8 * q);
#pragma unroll
    for (int n = 0; n < 4; ++n) { const int dvt = (w >> 2) * 4 + n;
        f32x4 acc = {0.f, 0.f, 0.f, 0.f};
        acc = mfma_safe(a0, *(const LAS bf16x8*)(Vt + (dvt * 16 + r) * LP + 8 * q), acc);
        acc = mfma_safe(a1, *(const LAS bf16x8*)(Vt + (dvt * 16 + r) * LP + 32 + 8 * q), acc);
#pragma unroll
        for (int j = 0; j < 4; ++j) DS[(dkt * 16 + 4 * q + j) * 128 + dvt * 16 + r] = f2bf(acc[j]); }
    __syncthreads();
}

__device__ __forceinline__ void gla_out(const Params& P, LAS unsigned char* lds, int c, int h) {
    const int tid = threadIdx.x, lane = tid & 63, w = tid >> 6, r = lane & 15, q = lane >> 4;
    unsigned char* ws = P.ws;
    const bf16_t* Z = (const bf16_t*)(ws + WS_Z); const float* LA = (const float*)(ws + WS_LA);
    LAS bf16_t* Qs = (LAS bf16_t*)(lds + L_QS); LAS bf16_t* Ks = (LAS bf16_t*)(lds + L_KS); LAS bf16_t* Vt = (LAS bf16_t*)(lds + L_VT);
    LAS bf16_t* St = (LAS bf16_t*)(lds + L_ST); LAS bf16_t* Ps = (LAS bf16_t*)(lds + L_PS); LAS float* tot = (LAS float*)(lds + L_TOT); LAS float* ssq = (LAS float*)(lds + L_SSQ);
    const int row0 = c * 64;
    float b[8], blast;
    gla_cumsum(LA, row0, h, w, lane, tot, b, blast);
#pragma unroll
    for (int i = 0; i < 8; ++i) { const int t = 8 * w + i; const size_t zr = (size_t)(row0 + t) * LDZ;
        const float e = __expf(b[i]);
        Qs[t * LP + lane] = f2bf(bf2f(Z[zr + ZQ + h * 64 + lane]) * e * 0.125f);
        Ks[t * LP + lane] = f2bf(bf2f(Z[zr + ZK + h * 64 + lane]) * __builtin_amdgcn_rcpf(e)); }
#pragma unroll
    for (int half = 0; half < 2; ++half) { unsigned vv[8];
#pragma unroll
        for (int i = 0; i < 8; ++i) vv[i] = Z[(size_t)(row0 + 8 * w + i) * LDZ + ZV + h * 128 + half * 64 + lane];
        u32x4 o; o.x = vv[0] | (vv[1] << 16); o.y = vv[2] | (vv[3] << 16); o.z = vv[4] | (vv[5] << 16); o.w = vv[6] | (vv[7] << 16);
        *(LAS u32x4*)(Vt + (half * 64 + lane) * LP + 8 * w) = o; }
    if (c < 512) { const bf16_t* Sp = (const bf16_t*)(ws + WS_SPB) + (size_t)(c * 4 + h) * 8192;
#pragma unroll
      for (int half = 0; half < 2; ++half) { unsigned vv[8];
#pragma unroll
        for (int i = 0; i < 8; ++i) vv[i] = Sp[(8 * w + i) * 128 + half * 64 + lane];
        u32x4 o; o.x = vv[0] | (vv[1] << 16); o.y = vv[2] | (vv[3] << 16); o.z = vv[4] | (vv[5] << 16); o.w = vv[6] | (vv[7] << 16);
        *(LAS u32x4*)(St + (half * 64 + lane) * LP + 8 * w) = o; }
    } else { const float* Sp = P.in[2] + (size_t)((c - 512) * 4 + h) * 8192;
#pragma unroll
      for (int half = 0; half < 2; ++half) { float sv[8];
#pragma unroll
        for (int i = 0; i < 8; ++i) sv[i] = Sp[(8 * w + i) * 128 + half * 64 + lane];
        u32x4 o; o.x = cvt_pk_bf16(sv[0], sv[1]); o.y = cvt_pk_bf16(sv[2], sv[3]); o.z = cvt_pk_bf16(sv[4], sv[5]); o.w = cvt_pk_bf16(sv[6], sv[7]);
        *(LAS u32x4*)(St + (half * 64 + lane) * LP + 8 * w) = o; } }
    __syncthreads();
#pragma unroll
    for (int i = 0; i < 2; ++i) { const int tile = w * 2 + i, tt = tile >> 2, st = tile & 3;
        f32x4 acc = {0.f, 0.f, 0.f, 0.f};
        if (st <= tt) {
#pragma unroll
            for (int k0 = 0; k0 < 64; k0 += 32)
                acc = mfma_safe(*(const LAS bf16x8*)(Qs + (tt * 16 + r) * LP + k0 + 8 * q), *(const LAS bf16x8*)(Ks + (st * 16 + r) * LP + k0 + 8 * q), acc);
        }
#pragma unroll
        for (int j = 0; j < 4; ++j) { const int t = tt * 16 + 4 * q + j, s = st * 16 + r; Ps[t * LP + s] = f2bf(s <= t ? acc[j] : 0.f); } }
    __syncthreads();
    const int tt = w >> 1, dh = w & 1;
    f32x4 oa[4];
#pragma unroll
    for (int n = 0; n < 4; ++n) oa[n] = (f32x4){0.f, 0.f, 0.f, 0.f};
#pragma unroll
    for (int k0 = 0; k0 < 64; k0 += 32) {
        const bf16x8 pa = *(const LAS bf16x8*)(Ps + (tt * 16 + r) * LP + k0 + 8 * q), qa = *(const LAS bf16x8*)(Qs + (tt * 16 + r) * LP + k0 + 8 * q);
#pragma unroll
        for (int n = 0; n < 4; ++n) { const int dv0 = (dh * 4 + n) * 16;
            oa[n] = mfma_safe(pa, *(const LAS bf16x8*)(Vt + (dv0 + r) * LP + k0 + 8 * q), oa[n]);
            oa[n] = mfma_safe(qa, *(const LAS bf16x8*)(St + (dv0 + r) * LP + k0 + 8 * q), oa[n]); }
    }
    float sq[4];
#pragma unroll
    for (int j = 0; j < 4; ++j) { float s = 0.f;
#pragma unroll
        for (int n = 0; n < 4; ++n) s += oa[n][j] * oa[n][j];
        s += __shfl_xor(s, 1); s += __shfl_xor(s, 2); s += __shfl_xor(s, 4); s += __shfl_xor(s, 8);
        sq[j] = s; }
    if (r == 0) {
#pragma unroll
        for (int j = 0; j < 4; ++j) ssq[(tt * 16 + 4 * q + j) * 2 + dh] = sq[j]; }
    __syncthreads();
    bf16_t* OG = (bf16_t*)(ws + WS_RB);
#pragma unroll
    for (int j = 0; j < 4; ++j) { const int t = tt * 16 + 4 * q + j; const size_t row = (size_t)(row0 + t);
        const float rs = rsqrtf((ssq[t * 2] + ssq[t * 2 + 1]) * (1.0f / 128.0f) + EPS);
#pragma unroll
        for (int n = 0; n < 4; ++n) { const int col = h * 128 + (dh * 4 + n) * 16 + r;
            OG[row * 512 + col] = f2bf(oa[n][j] * rs * P.in[12][col] * bf2f(Z[row * LDZ + ZR + col])); } }
    __syncthreads();
}

constexpr int S5_WAVE_LDS = 16384, S5_X_OFF = 8192, XP = 136;
template <bool FULL>
__device__ __forceinline__ void s5_item(const Params& P, const unsigned char* tb, LAS unsigned char* wl, int c, int g, int lane) {
    unsigned char* ws = P.ws;
    const int r = lane & 15, q = lane >> 4, row0 = c * 64;
    const bf16_t* Z = (const bf16_t*)(ws + WS_Z);
    LAS float* BU = (LAS float*)wl; LAS bf16_t* X = (LAS bf16_t*)(wl + S5_X_OFF);
    float xr = 0.f, xi = 0.f;
    if (FULL) { const float* x0 = (c < 512) ? (const float*)(ws + WS_XP) + ((size_t)(c * 32 + g) * 64 + lane) * 2 : P.in[3] + ((size_t)((c - 512) * 32 + g) * 64 + lane) * 2;
        xr = x0[0]; xi = x0[1]; }
    const float ar = ((const float*)(tb + T_ABAR))[(g * 64 + lane) * 2], ai = ((const float*)(tb + T_ABAR))[(g * 64 + lane) * 2 + 1];
    const bf16_t* BB = (const bf16_t*)(tb + T_BB); const bf16_t* CC = (const bf16_t*)(tb + T_CC);
    bf16x8 cc[4];
    if (FULL) {
#pragma unroll
        for (int kk = 0; kk < 4; ++kk) cc[kk] = *(const bf16x8*)(CC + (g * 16 + r) * 128 + kk * 32 + 8 * q); }
    for (int sb = 0; sb < 4; ++sb) {
        const bf16x8 a = *(const bf16x8*)(Z + (size_t)(row0 + sb * 16 + r) * LDZ + ZU + g * 16 + 8 * (q & 1));
#pragma unroll
        for (int n = 0; n < 8; ++n) {
            const bf16x8 bb = *(const bf16x8*)(BB + (g * 128 + n * 16 + r) * 32 + 8 * q);
            f32x4 acc = {0.f, 0.f, 0.f, 0.f};
            acc = mfma_safe(a, bb, acc);
#pragma unroll
            for (int j = 0; j < 4; ++j) BU[(4 * q + j) * 128 + n * 16 + r] = acc[j];
        }
        LDS_FENCE();
#pragma unroll 4
        for (int t = 0; t < 16; ++t) {
            const float br = BU[t * 128 + lane], bi = BU[t * 128 + 64 + lane];
            const float nxr = ar * xr - ai * xi + br, nxi = ar * xi + ai * xr + bi;
            xr = nxr; xi = nxi;
            if (FULL) { X[t * XP + lane] = f2bf(xr); X[t * XP + 64 + lane] = f2bf(xi); }
        }
        LDS_FENCE();
        if (FULL) {
            f32x4 y = {0.f, 0.f, 0.f, 0.f};
#pragma unroll
            for (int kk = 0; kk < 4; ++kk) y = mfma_safe(*(const LAS bf16x8*)(X + r * XP + kk * 32 + 8 * q), cc[kk], y);
            const float dsk = P.in[21][g * 16 + r];
            bf16_t* G5 = (bf16_t*)(ws + WS_RB) + (size_t)M * 512;
#pragma unroll
            for (int j = 0; j < 4; ++j) { const size_t row = (size_t)(row0 + sb * 16 + 4 * q + j);
                const float yv = y[j] + dsk * bf2f(Z[row * LDZ + ZU + g * 16 + r]);
                const float gl = yv * fsigmoid(1.5957691216f * (yv + 0.044715f * yv * yv * yv));
                G5[row * 512 + g * 16 + r] = f2bf(gl); }
            LDS_FENCE();
        }
    }
    if (!FULL) { float* E = (float*)(ws + WS_E) + ((size_t)(c * 32 + g) * 64 + lane) * 2; E[0] = xr; E[1] = xi; }
    else if (c >= 512) { float* o = P.out + O_S5S + ((size_t)((c - 512) * 32 + g) * 64 + lane) * 2; o[0] = xr; o[1] = xi; }
}

__device__ __forceinline__ void carry_phase(const Params& P, const unsigned char* tb) {
    unsigned char* ws = P.ws;
    const int gid = blockIdx.x * 512 + threadIdx.x, NT = gridDim.x * 512;
    const bf16_t* DS = (const bf16_t*)(ws + WS_R2); bf16_t* SPB = (bf16_t*)(ws + WS_SPB); const float* DEC = (const float*)(ws + WS_DEC);
    for (int e = gid; e < 65536; e += NT) {
        const int bh = e >> 13, el = e & 8191, dk = el >> 7, bb = bh >> 2, h = bh & 3;
        float S = 0.f;
        for (int c = 0; c < 256; c += 8) {
            float v[8], d[8];
#pragma unroll
            for (int i = 0; i < 8; ++i) { const int ch = bb * 256 + c + i; v[i] = bf2f(DS[(size_t)(ch * 4 + h) * 8192 + el]); d[i] = DEC[(ch * 4 + h) * 64 + dk]; }
#pragma unroll
            for (int i = 0; i < 8; ++i) { const int ch = bb * 256 + c + i; SPB[(size_t)(ch * 4 + h) * 8192 + el] = f2bf(S); S = d[i] * S + v[i]; }
        }
        P.out[O_GLAP + e] = S;
    }
    for (int e = gid; e < 524288; e += NT) {
        const int sh = e >> 13, el = e & 8191, dk = el >> 7, ch = 512 * 4 + sh;
        P.out[O_GLAS + e] = DEC[ch * 64 + dk] * P.in[2][e] + bf2f(DS[(size_t)ch * 8192 + el]);
    }
    for (int e = gid; e < 4096; e += NT) {
        const int bb = e >> 11, gp = e & 2047;
        const float ar = ((const float*)(tb + T_ABAR64))[gp * 2], ai = ((const float*)(tb + T_ABAR64))[gp * 2 + 1];
        const f32x2* E = (const f32x2*)(ws + WS_E); f32x2* XPv = (f32x2*)(ws + WS_XP);
        float xr = 0.f, xi = 0.f;
        for (int c = 0; c < 256; c += 8) {
            f32x2 v[8];
#pragma unroll
            for (int i = 0; i < 8; ++i) v[i] = E[(size_t)(bb * 256 + c + i) * 2048 + gp];
#pragma unroll
            for (int i = 0; i < 8; ++i) { XPv[(size_t)(bb * 256 + c + i) * 2048 + gp] = (f32x2){xr, xi};
                const float nxr = ar * xr - ai * xi + v[i].x, nxi = ar * xi + ai * xr + v[i].y; xr = nxr; xi = nxi; }
        }
        P.out[O_S5P + (size_t)e * 2] = xr; P.out[O_S5P + (size_t)e * 2 + 1] = xi;
    }
}

__global__ void __launch_bounds__(512, 2) fwd_kernel(Params P) {
    extern __shared__ __attribute__((aligned(16))) unsigned char smem[];
    LAS unsigned char* lds = (LAS unsigned char*)smem;
    cg::grid_group grid = cg::this_grid();
    unsigned char* ws = P.ws;
    const int lo = P.ph_lo, hi = P.ph_hi;
    const int G = gridDim.x, bx = blockIdx.x;
    const int tid = threadIdx.x, lane = tid & 63, wave = tid >> 6;
#define IN(k) (lo <= (k) && (k) < hi)
#define SEAM(k) do { if (IN(k) && IN((k) + 1)) { asm volatile("s_waitcnt vmcnt(0)" ::: "memory"); __syncthreads(); grid.sync(); \
        __builtin_amdgcn_fence(__ATOMIC_ACQUIRE, "agent"); asm volatile("s_waitcnt vmcnt(0)" ::: "memory"); __syncthreads(); } } while (0)
    float* Y = P.out + O_Y;
    bf16_t* RB = (bf16_t*)(ws + WS_RB); bf16_t* ZB = (bf16_t*)(ws + WS_Z); bf16_t* ACT = ZB; bf16_t* GLU = (bf16_t*)(ws + WS_LA); bf16_t* TM = (bf16_t*)(ws + WS_R2);
    float* LA = (float*)(ws + WS_LA);
    float* SSX = (float*)(ws + WS_SSX); float* SSH = (float*)(ws + WS_SSH); float* SS2 = (float*)(ws + WS_SS2); float* SS3 = (float*)(ws + WS_SS3);

    pg8::XMap xm;
    {
        unsigned* ctl = (unsigned*)(ws + WS_CTL) + 64 * (hi - lo == N_PHASES ? 0 : 1 + lo);
        LAS unsigned* lw = (LAS unsigned*)(lds + LDS_BYTES - 16);
        const unsigned xcc = (unsigned)__builtin_amdgcn_s_getreg((3 << 11) | 20) & 0xFu;
        if (tid == 0) { lw[0] = __hip_atomic_fetch_add(ctl + xcc, 1u, RLX_AGENT); lw[1] = xcc; }
        asm volatile("s_waitcnt vmcnt(0)" ::: "memory"); __syncthreads(); grid.sync(); __syncthreads();
        int nx = 0, xi = 0;
        for (int j = 0; j < 16; ++j) { const unsigned cj = __hip_atomic_load(ctl + j, RLX_AGENT); if (cj) { if (j < (int)lw[1]) ++xi; ++nx; } }
        xm.nx = nx; xm.xi = xi; xm.rank = (int)lw[0]; xm.nb = (int)__hip_atomic_load(ctl + lw[1], RLX_AGENT);
        __syncthreads();
    }
    const int NTX = pg8::xm_ntiles(xm, M / 256);
    if (IN(0)) p0_phase(P, lds, xm);
    SEAM(0);
    if (IN(1)) { pg8::Gemm g{RB, (const bf16_t*)(ws + WS_WGU1), M, 5632, 1024}; pg8::XcdOrder S; S.init(M, 5632, xm);
        EpiGated<false> E{ACT, FF, SSX, 1}; pg8::gemm_phase(lds, g, S, E); }
    SEAM(1);
    if (IN(2)) { pg8::Gemm g{ACT, (const bf16_t*)(ws + WS_WD1), M, 1024, FF}; pg8::XcdOrder S; S.init(M, 1024, xm);
        EpiRes E{P.in[0], P.in[1], Y, RB, SSH, 0.5f}; pg8::gemm_phase(lds, g, S, E); }
    SEAM(2);
    if (IN(3)) { pg8::Gemm g{RB, (const bf16_t*)(ws + WS_WIN), M, NZ, 1024}; pg8::XcdOrder S; S.init(M, NZ, xm);
        EpiZ E{ZB, LA, SSH, P.in[11]}; pg8::gemm_phase(lds, g, S, E); }
    SEAM(3);
    if (IN(4)) {
        for (int u = xm.rank; u < NTX * 16; u += xm.nb) gla_local(P, lds, (xm.xi + (u >> 4) * xm.nx) * 4 + ((u >> 2) & 3), u & 3);
        if (wave < S5_NW) for (int u = xm.rank * S5_NW + wave; u < NTX * 128; u += xm.nb * S5_NW) { const int c = (xm.xi + (u >> 7) * xm.nx) * 4 + ((u >> 5) & 3);
            if (c < 512) s5_item<false>(P, ws + WS_TBL + (size_t)xm.xi * TBL_STRIDE, lds + wave * S5_WAVE_LDS, c, u & 31, lane); }
    }
    SEAM(4);
    if (IN(5)) carry_phase(P, ws + WS_TBL + (size_t)xm.xi * TBL_STRIDE);
    SEAM(5);
    if (IN(6)) {
        for (int u = xm.rank; u < NTX * 16; u += xm.nb) gla_out(P, lds, (xm.xi + (u >> 4) * xm.nx) * 4 + ((u >> 2) & 3), u & 3);
        if (wave < S5_NW) for (int u = xm.rank * S5_NW + wave; u < NTX * 128; u += xm.nb * S5_NW) s5_item<true>(P, ws + WS_TBL + (size_t)xm.xi * TBL_STRIDE, lds + wave * S5_WAVE_LDS, (xm.xi + (u >> 7) * xm.nx) * 4 + ((u >> 5) & 3), u & 31, lane);
        __syncthreads();
    }
    SEAM(6);
    if (IN(7)) {
        { pg8::Gemm g{RB + (size_t)M * 512, (const bf16_t*)(ws + WS_WGLU), M, 1024, 512}; pg8::XcdOrder S; S.init(M, 1024, xm);
          EpiGated<true> E{GLU, 512, nullptr, 0}; pg8::gemm_phase(lds, g, S, E); }
        { pg8::Gemm g{RB, (const bf16_t*)(ws + WS_WGO), M, 1024, 512}; pg8::XcdOrder S; S.init(M, 1024, xm);
          EpiMix<false> E{TM, ZB, ZGG}; pg8::gemm_phase(lds, g, S, E); }
    }
    SEAM(7);
    if (IN(8)) { pg8::Gemm g{GLU, (const bf16_t*)(ws + WS_WS5O), M, 1024, 512}; pg8::XcdOrder S; S.init(M, 1024, xm);
        EpiMix<true> E{TM, ZB, ZG5}; pg8::gemm_phase(lds, g, S, E); }
    SEAM(8);
    if (IN(9)) { pg8::Gemm g{TM, (const bf16_t*)(ws + WS_WOUT), M, 1024, 1024}; pg8::XcdOrder S; S.init(M, 1024, xm);
        EpiRes E{Y, Y + (size_t)MP * 1024, Y, RB, SS2, 1.0f}; pg8::gemm_phase(lds, g, S, E); }
    SEAM(9);
    if (IN(10)) { pg8::Gemm g{RB, (const bf16_t*)(ws + WS_WGU2), M, 5632, 1024}; pg8::XcdOrder S; S.init(M, 5632, xm);
        EpiGated<false> E{ACT, FF, SS2, 16}; pg8::gemm_phase(lds, g, S, E); }
    SEAM(10);
    if (IN(11)) { pg8::Gemm g{ACT, (const bf16_t*)(ws + WS_WD2), M, 1024, FF}; pg8::XcdOrder S; S.init(M, 1024, xm);
        EpiRes E{Y, Y + (size_t)MP * 1024, Y, nullptr, SS3, 0.5f}; pg8::gemm_phase(lds, g, S, E); }
    SEAM(11);
    if (IN(12)) {
        const float* gf = P.in[30];
        for (int u = xm.rank * 8 + wave; u < NTX * 256; u += xm.nb * 8) {
            const int row = (xm.xi + (u >> 8) * xm.nx) * 256 + (u & 255);
            const float rs = row_rstd(SS3, 16, row);
            f32x4* yr = (f32x4*)(Y + (size_t)row * 1024);
#pragma unroll
            for (int j = 0; j < 4; ++j) { const f32x4 v = yr[lane + 64 * j], gg = ((const f32x4*)gf)[lane + 64 * j]; yr[lane + 64 * j] = v * rs * gg; }
        }
        asm volatile("s_waitcnt vmcnt(0)" ::: "memory"); __threadfence_system(); asm volatile("s_waitcnt vmcnt(0)" ::: "memory");
    }
}

extern "C" void kernel_launch(void* const* d_in, const int* in_sizes, int n_in, void* d_out, int out_size, void* d_ws, size_t ws_size, hipStream_t stream) {
    static int grid_blocks = 0;
    if (grid_blocks == 0) {
        if (n_in != 31 || ws_size < WS_END) { fprintf(stderr, "kernel_launch: need 31 inputs and >= %zu bytes of workspace; got %d, %zu\n", (size_t)WS_END, n_in, ws_size); grid_blocks = -1; return; }
        int dev = 0, cus = 0, per_cu = 0;
        hipGetDevice(&dev);
        hipDeviceGetAttribute(&cus, hipDeviceAttributeMultiprocessorCount, dev);
        if (hipFuncSetAttribute((const void*)fwd_kernel, hipFuncAttributeMaxDynamicSharedMemorySize, LDS_BYTES) != hipSuccess) { fprintf(stderr, "kernel_launch: hipFuncSetAttribute failed\n"); grid_blocks = -1; return; }
        if (hipOccupancyMaxActiveBlocksPerMultiprocessor(&per_cu, (const void*)fwd_kernel, 512, LDS_BYTES) != hipSuccess || per_cu < 1) { fprintf(stderr, "kernel_launch: occupancy query gave %d\n", per_cu); per_cu = 1; }
        (void)hipGetLastError();
        grid_blocks = cus * 1;
        fprintf(stderr, "kernel_launch: cus %d per_cu %d grid %d\n", cus, per_cu, grid_blocks);
    }
    if (grid_blocks < 0) return;
    hipMemsetAsync((unsigned char*)d_ws + WS_CTL, 0, 8192, stream);
    Params p{};
    for (int i = 0; i < 31; ++i) p.in[i] = (const float*)d_in[i];
    p.out = (float*)d_out; p.ws = (unsigned char*)d_ws;
    p.ph_lo = 0; p.ph_hi = N_PHASES;
    void* args[] = {&p};
    hipError_t e = hipLaunchCooperativeKernel((const void*)fwd_kernel, dim3(grid_blocks), dim3(512), args, LDS_BYTES, stream);
    if (e != hipSuccess) fprintf(stderr, "cooperative launch failed: %s (grid %d)\n", hipGetErrorString(e), grid_blocks);
}
```

```cpp
#include <hip/hip_runtime.h>
#include <hip/hip_cooperative_groups.h>
#include <cstdio>
#include <cstdint>
namespace cg = cooperative_groups;


#define LAS __attribute__((address_space(3)))
typedef unsigned short bf16_t;
typedef short bf16x8 __attribute__((ext_vector_type(8)));
typedef float f32x4 __attribute__((ext_vector_type(4)));
typedef float f32x2 __attribute__((ext_vector_type(2)));
typedef unsigned u32x4 __attribute__((ext_vector_type(4)));
typedef unsigned u32x2 __attribute__((ext_vector_type(2)));

constexpr int MP = 32768;
constexpr int MS = 1024;
constexpr int M = MP + MS;
constexpr int D = 1024, FF = 2816;
constexpr int NZ = 4352;
constexpr int LDZ = 4096;
constexpr int ZQ = 0, ZK = 256, ZV = 512, ZR = 1024, ZU = 1536, ZGG = 2048, ZG5 = 3072;
constexpr int NCH = 528;
constexpr float EPS = 1e-6f;

constexpr size_t SZ_WGU = (size_t)5632 * 1024 * 2, SZ_WD = (size_t)1024 * 2816 * 2, SZ_WIN = (size_t)NZ * 1024 * 2;
constexpr size_t SZ_W512 = (size_t)1024 * 512 * 2, SZ_WOUT = (size_t)1024 * 1024 * 2;
constexpr size_t WS_WGU1 = 0;
constexpr size_t WS_WD1 = WS_WGU1 + SZ_WGU;
constexpr size_t WS_WIN = WS_WD1 + SZ_WD;
constexpr size_t WS_WGLU = WS_WIN + SZ_WIN;
constexpr size_t WS_WGO = WS_WGLU + SZ_W512;
constexpr size_t WS_WS5O = WS_WGO + SZ_W512;
constexpr size_t WS_WOUT = WS_WS5O + SZ_W512;
constexpr size_t WS_WGU2 = WS_WOUT + SZ_WOUT;
constexpr size_t WS_WD2 = WS_WGU2 + SZ_WGU;
constexpr size_t WS_RB = WS_WD2 + SZ_WD;
constexpr size_t SZ_RB = (size_t)M * 1024 * 2;
constexpr size_t WS_Z = WS_RB + SZ_RB;
constexpr size_t SZ_Z = (size_t)M * LDZ * 2;
constexpr size_t WS_LA = WS_Z + SZ_Z;
constexpr size_t SZ_LA = (size_t)M * 256 * 4;
constexpr size_t WS_R2 = WS_LA + SZ_LA;
constexpr size_t WS_SPB = WS_R2 + (size_t)NCH * 4 * 8192 * 2;
constexpr size_t SZ_R2 = (size_t)M * 1024 * 2;
constexpr size_t WS_SSX = WS_R2 + SZ_R2;
constexpr size_t WS_SSH = WS_SSX + (size_t)M * 4;
constexpr size_t WS_SS2 = WS_SSH + (size_t)M * 64;
constexpr size_t WS_SS3 = WS_SS2 + (size_t)M * 64;
constexpr size_t WS_DEC = WS_SS3 + (size_t)M * 64;
constexpr size_t WS_E = WS_DEC + (size_t)NCH * 4 * 64 * 4;
constexpr size_t WS_TBL = WS_E + (size_t)512 * 32 * 64 * 2 * 4;
constexpr size_t T_ABAR = 0, T_ABAR64 = 16384, T_BB = 32768, T_CC = T_BB + 262144, TBL_STRIDE = T_CC + 131072;
constexpr size_t WS_CC_END = WS_TBL + 16 * TBL_STRIDE;
constexpr size_t WS_XP = WS_CC_END;
constexpr size_t WS_CTL = WS_XP + (size_t)512 * 32 * 64 * 2 * 4;
constexpr size_t WS_END = WS_CTL + 8192;

constexpr size_t O_Y = 0, O_GLAP = (size_t)M * 1024, O_S5P = O_GLAP + 65536, O_GLAS = O_S5P + 8192, O_S5S = O_GLAS + 524288;

constexpr int LDS_BYTES = 147456;
constexpr int N_PHASES = 13;
#ifndef TIMING_REP_MIXER
#define TIMING_REP_MIXER 1
#endif
constexpr int S5_NW = 4;

struct Params {
    const float* in[31];
    float* out;
    unsigned char* ws;
    int ph_lo, ph_hi;
};

__device__ __forceinline__ unsigned cvt_pk_bf16(float lo, float hi) { unsigned r; asm volatile("v_cvt_pk_bf16_f32 %0, %1, %2" : "=v"(r) : "v"(lo), "v"(hi)); return r; }
__device__ __forceinline__ bf16_t f2bf(float f) { return (bf16_t)(cvt_pk_bf16(f, 0.f) & 0xffffu); }
__device__ __forceinline__ float bf2f(bf16_t b) { return __uint_as_float(((unsigned)b) << 16); }
__device__ __forceinline__ float bflo(unsigned w) { return __uint_as_float(w << 16); }
__device__ __forceinline__ float bfhi(unsigned w) { return __uint_as_float(w & 0xffff0000u); }
__device__ __forceinline__ float fsigmoid(float x) { return __builtin_amdgcn_rcpf(1.0f + __expf(-x)); }
__device__ __forceinline__ float fsilu(float x) { return x * fsigmoid(x); }
__device__ __forceinline__ float wave_sum(float v) {
#pragma unroll
    for (int o = 1; o < 64; o <<= 1) v += __shfl_xor(v, o);
    return v;
}
__device__ __forceinline__ float row_rstd(const float* ss, int np, int row) {
    float s;
    if (np == 1) s = ss[row];
    else { const f32x4* p = (const f32x4*)(ss + (size_t)row * 16); f32x4 a = p[0], b = p[1], c = p[2], d = p[3];
        s = ((a.x + a.y) + (a.z + a.w)) + ((b.x + b.y) + (b.z + b.w)) + ((c.x + c.y) + (c.z + c.w)) + ((d.x + d.y) + (d.z + d.w)); }
    return rsqrtf(s * (1.0f / 1024.0f) + EPS);
}
#define RLX_AGENT __ATOMIC_RELAXED, __HIP_MEMORY_SCOPE_AGENT
#define LDS_FENCE() asm volatile("s_waitcnt lgkmcnt(0)" ::: "memory")
__device__ __forceinline__ f32x4 mfma_safe(bf16x8 a, bf16x8 b, f32x4 acc) {
    asm volatile("s_nop 1\n\tv_mfma_f32_16x16x32_bf16 %0, %1, %2, %0\n\ts_nop 7\n\ts_nop 7" : "+v"(acc) : "v"(a), "v"(b));
    return acc;
}


namespace pg8 {
constexpr int BM = 256, BK = 64, HALF = 128, HTB = HALF * BK * 2, STAGE_BYTES = 8 * HTB, NXCD = 8, WGM = 8;
__host__ __device__ __forceinline__ int lds_byte(int r, int c) { const int st = (r >> 4) * 2 + (c >> 5), rr = r & 15, cc = c & 31, ob = rr * 64 + cc * 2; return st * 1024 + (ob ^ (((ob >> 9) & 1) << 5)); }
__host__ __device__ __forceinline__ void stage_rc(int b, int& R, int& C) { const int st = b / 1024, sb = b % 1024, swz = sb ^ (((sb >> 9) & 1) << 5); R = (st >> 1) * 16 + swz / 64; C = (st & 1) * 32 + (swz % 64) / 2; }
__host__ __device__ __forceinline__ int perm32(int rho) { const int n = rho >> 4, i = rho & 15; return 8 * (i >> 2) + 4 * n + (i & 3); }
struct Unit { int pm, pn; };
struct Gemm { const bf16_t* A; const bf16_t* Bt; int M, N, K; };
struct StaticOrder {
    int nM, nN, nwg, G, c;
    __host__ __device__ void init(int M_, int N_, int G_, int c_) { nM = M_ / BM; nN = N_ / BM; nwg = nM * nN; G = G_; c = c_; }
    __host__ __device__ bool next(int i, Unit& u) const {
        const long L = (long)i * G + c; if (L >= nwg) return false;
        int wgid = (int)L; { const int q = nwg / NXCD, r = nwg % NXCD, xcd = wgid % NXCD, off = wgid / NXCD; wgid = (xcd < r ? xcd * (q + 1) : r * (q + 1) + (xcd - r) * q) + off; }
        const int nig = WGM * nN, gid = wgid / nig, fm = gid * WGM, gsz = (nM - fm) < WGM ? (nM - fm) : WGM;
        u.pm = fm + ((wgid % nig) % gsz); u.pn = (wgid % nig) / gsz; return true;
    }
};

struct XMap { int nx, xi, rank, nb; };
__device__ __forceinline__ int xm_ntiles(const XMap& x, int nM) { return (nM - x.xi + x.nx - 1) / x.nx; }
struct XcdOrder {
    int nN, nt, nu, rank, nb, xi, nx;
    __device__ void init(int M_, int N_, const XMap& x) { nN = N_ / BM; nt = xm_ntiles(x, M_ / BM); nu = nt * nN; rank = x.rank; nb = x.nb; xi = x.xi; nx = x.nx; }
    __device__ bool next(int i, Unit& u) const {
        const int L = i * nb + rank; if (L >= nu) return false;
        const int per = 4 * nN, g = L / per, l = L % per, gsz = (nt - 4 * g) < 4 ? (nt - 4 * g) : 4;
        u.pm = xi + (4 * g + l % gsz) * nx; u.pn = l / gsz; return true;
    }
};

template <class Epi, class Sched>
__device__ __forceinline__ void gemm_phase(LAS unsigned char* lds, const Gemm g, const Sched& S, const Epi& E) {
    const int tid = threadIdx.x, wid = __builtin_amdgcn_readfirstlane(tid >> 6), lane = tid & 63, wr = wid >> 2, wc = wid & 3, fr = lane & 15, fq = lane >> 4;
    const int K = g.K, nt = K / BK;
    unsigned voffA[2], voffB[2];
#pragma unroll
    for (int i = 0; i < 2; ++i) { int R, C; stage_rc(tid * 16 + i * 8192, R, C); const int Rb = Epi::PERM ? ((R & ~31) + perm32(R & 31)) : R;
        voffA[i] = (unsigned)(R * K + C) * 2u; voffB[i] = (unsigned)(Rb * K + C) * 2u; }
    const size_t kstep = (size_t)(BK * 2);
    const size_t hstep = (size_t)HALF * K * 2;
    const size_t tstep = 2 * hstep;
    const unsigned ldsw = (unsigned)wid * 1024u;
    const int aoff = lds_byte(wr * 64 + fr, fq * 8), boff = lds_byte(wc * 32 + fr, fq * 8);
#define PG8_SA(b, h) (((b) * 2 + (h)) * HTB)
#define PG8_SB(b, h) ((4 + (b) * 2 + (h)) * HTB)
#define PG8_STAGE(bufoff, gbase, voff) do { _Pragma("unroll") for (int _i = 0; _i < 2; ++_i) \
        __builtin_amdgcn_global_load_lds((const unsigned*)((const char*)(gbase) + (voff)[_i]), (LAS unsigned*)(lds + (bufoff) + ldsw + _i * 8192), 16, 0, 0); } while (0)
#define PG8_LDA(dst, b, h) do { _Pragma("unroll") for (int m = 0; m < 4; ++m) _Pragma("unroll") for (int k = 0; k < 2; ++k) dst[m][k] = *(const LAS bf16x8*)(lds + PG8_SA(b, h) + aoff + m * 2048 + k * 1024); } while (0)
#define PG8_LDB(dst, b, h) do { _Pragma("unroll") for (int n = 0; n < 2; ++n) _Pragma("unroll") for (int k = 0; k < 2; ++k) dst[n][k] = *(const LAS bf16x8*)(lds + PG8_SB(b, h) + boff + n * 2048 + k * 1024); } while (0)
#define PG8_MMA(ai, bj, At, Bt) do { __builtin_amdgcn_s_setprio(1); _Pragma("unroll") for (int m = 0; m < 4; ++m) _Pragma("unroll") for (int n = 0; n < 2; ++n) _Pragma("unroll") for (int k = 0; k < 2; ++k) \
        acc[ai][bj][m][n] = __builtin_amdgcn_mfma_f32_16x16x32_bf16(Bt[n][k], At[m][k], acc[ai][bj][m][n], 0, 0, 0); __builtin_amdgcn_s_setprio(0); } while (0)
#define PG8_WAIT_V(n) asm volatile("s_waitcnt vmcnt(" #n ")" ::: "memory")
#define PG8_WAIT_L(n) asm volatile("s_waitcnt lgkmcnt(" #n ")" ::: "memory")
#define PG8_BAR __builtin_amdgcn_s_barrier()
#define PG8_SCHED __builtin_amdgcn_sched_barrier(0)
    Unit cur, nxt; int ui = 0;
    if (!S.next(0, cur)) return;
    f32x4 acc[2][2][4][2];
#pragma unroll
    for (int a = 0; a < 2; ++a)
#pragma unroll
        for (int b = 0; b < 2; ++b)
#pragma unroll
            for (int m = 0; m < 4; ++m)
#pragma unroll
                for (int n = 0; n < 2; ++n) acc[a][b][m][n] = (f32x4){0.f, 0.f, 0.f, 0.f};
    bf16x8 At[4][2], B0[2][2], B1[2][2];
    const char* cA = (const char*)g.A + (size_t)cur.pm * tstep; const char* cB = (const char*)g.Bt + (size_t)cur.pn * tstep;
    PG8_STAGE(PG8_SB(0, 0), cB, voffB); PG8_STAGE(PG8_SA(0, 0), cA, voffA); PG8_STAGE(PG8_SB(0, 1), cB + hstep, voffB); PG8_STAGE(PG8_SA(0, 1), cA + hstep, voffA);
    if (wr == 1) PG8_BAR;
    PG8_WAIT_V(4); PG8_BAR;
    PG8_STAGE(PG8_SB(1, 0), cB + kstep, voffB); PG8_STAGE(PG8_SA(1, 0), cA + kstep, voffA); PG8_STAGE(PG8_SB(1, 1), cB + hstep + kstep, voffB);
    PG8_WAIT_V(6); PG8_BAR;
    for (;;) {
        const bool has_next = S.next(ui + 1, nxt);
        const char* nA = has_next ? (const char*)g.A + (size_t)nxt.pm * tstep : cA; const char* nB = has_next ? (const char*)g.Bt + (size_t)nxt.pn * tstep : cB;
        for (int t = 0; t < nt; t += 2) {
            const bool last = (t == nt - 2);
            const char* a1 = cA + (size_t)(t + 1) * kstep;
            const char* a2 = last ? nA : cA + (size_t)(t + 2) * kstep; const char* b2 = last ? nB : cB + (size_t)(t + 2) * kstep;
            const char* a3 = a2 + kstep; const char* b3 = b2 + kstep;
            PG8_LDB(B0, 0, 0); PG8_SCHED; PG8_LDA(At, 0, 0); PG8_STAGE(PG8_SA(1, 1), a1 + hstep, voffA);
            PG8_WAIT_L(8); PG8_BAR; PG8_WAIT_L(0); PG8_MMA(0, 0, At, B0); PG8_BAR; PG8_SCHED;
            PG8_LDB(B1, 0, 1); PG8_STAGE(PG8_SB(0, 0), b2, voffB);
            PG8_BAR; PG8_WAIT_L(0); PG8_MMA(0, 1, At, B1); PG8_BAR;
            PG8_LDA(At, 0, 1); PG8_STAGE(PG8_SA(0, 0), a2, voffA);
            PG8_BAR; PG8_WAIT_L(0); PG8_MMA(1, 0, At, B0); PG8_BAR; PG8_SCHED;
            PG8_STAGE(PG8_SB(0, 1), b2 + hstep, voffB);
            PG8_WAIT_V(6); PG8_BAR; PG8_MMA(1, 1, At, B1); PG8_BAR;
            PG8_LDB(B0, 1, 0); PG8_SCHED; PG8_LDA(At, 1, 0); PG8_STAGE(PG8_SA(0, 1), a2 + hstep, voffA);
            PG8_WAIT_L(8); PG8_BAR; PG8_WAIT_L(0); PG8_MMA(0, 0, At, B0); PG8_BAR; PG8_SCHED;
            PG8_LDB(B1, 1, 1); PG8_STAGE(PG8_SB(1, 0), b3, voffB);
            PG8_BAR; PG8_WAIT_L(0); PG8_MMA(0, 1, At, B1); PG8_BAR;
            PG8_LDA(At, 1, 1); PG8_STAGE(PG8_SA(1, 0), a3, voffA);
            PG8_BAR; PG8_WAIT_L(0); PG8_MMA(1, 0, At, B0); PG8_BAR; PG8_SCHED;
            PG8_STAGE(PG8_SB(1, 1), b3 + hstep, voffB);
            PG8_WAIT_V(6); PG8_BAR; PG8_MMA(1, 1, At, B1); PG8_BAR;
        }
        E(acc, cur, wr, wc, fr, fq);
        if (!has_next) break;
#pragma unroll
        for (int a = 0; a < 2; ++a)
#pragma unroll
            for (int b = 0; b < 2; ++b)
#pragma unroll
                for (int m = 0; m < 4; ++m)
#pragma unroll
                    for (int n = 0; n < 2; ++n) acc[a][b][m][n] = (f32x4){0.f, 0.f, 0.f, 0.f};
        cur = nxt; cA = nA; cB = nB; ++ui;
    }
    PG8_WAIT_V(0);
    if (wr == 0) PG8_BAR;
    PG8_BAR;
#undef PG8_SA
#undef PG8_SB
#undef PG8_STAGE
#undef PG8_LDA
#undef PG8_LDB
#undef PG8_MMA
#undef PG8_WAIT_V
#undef PG8_WAIT_L
#undef PG8_BAR
#undef PG8_SCHED
}
}
using pg8::Unit;

typedef f32x4 AccT[2][2][4][2];

template <bool GLU> struct EpiGated {
    static constexpr bool PERM = true;
    bf16_t* O; int ldc; const float* ss; int np;
    __device__ __forceinline__ void operator()(const AccT& acc, const Unit& u, int wr, int wc, int fr, int fq) const {
        const int row0 = u.pm * 256 + wr * 64 + fr, col0 = u.pn * 128 + wc * 32 + 8 * fq;
#pragma unroll
        for (int ai = 0; ai < 2; ++ai)
#pragma unroll
            for (int m = 0; m < 4; ++m) {
                const int row = row0 + ai * 128 + m * 16;
                float o[8];
                if (GLU) {
#pragma unroll
                    for (int n = 0; n < 2; ++n)
#pragma unroll
                        for (int j = 0; j < 4; ++j) o[n * 4 + j] = acc[ai][0][m][n][j] * fsigmoid(acc[ai][1][m][n][j]);
                } else {
                    const float rs = row_rstd(ss, np, row);
#pragma unroll
                    for (int n = 0; n < 2; ++n)
#pragma unroll
                        for (int j = 0; j < 4; ++j) o[n * 4 + j] = fsilu(acc[ai][0][m][n][j] * rs) * (acc[ai][1][m][n][j] * rs);
                }
                u32x4 w; w.x = cvt_pk_bf16(o[0], o[1]); w.y = cvt_pk_bf16(o[2], o[3]); w.z = cvt_pk_bf16(o[4], o[5]); w.w = cvt_pk_bf16(o[6], o[7]);
                *(u32x4*)(O + (size_t)row * ldc + col0) = w;
            }
    }
};

struct EpiRes {
    static constexpr bool PERM = false;
    const float* res0; const float* res1; float* out; bf16_t* outb; float* ssout; float scale;
    __device__ __forceinline__ void operator()(const AccT& acc, const Unit& u, int wr, int wc, int fr, int fq) const {
        const int row0 = u.pm * 256 + wr * 64 + fr, col0 = u.pn * 256 + wc * 32 + 4 * fq;
#pragma unroll
        for (int ai = 0; ai < 2; ++ai)
#pragma unroll
            for (int m = 0; m < 4; ++m) {
                const int row = row0 + ai * 128 + m * 16;
                const float* rp = (row < MP ? res0 + (size_t)row * 1024 : res1 + (size_t)(row - MP) * 1024) + col0;
                float* op = out + (size_t)row * 1024 + col0;
                float ssq = 0.f;
#pragma unroll
                for (int bj = 0; bj < 2; ++bj)
#pragma unroll
                    for (int n = 0; n < 2; ++n) {
                        const f32x4 r4 = *(const f32x4*)(rp + bj * 128 + n * 16);
                        const f32x4 v = r4 + acc[ai][bj][m][n] * scale;
                        *(f32x4*)(op + bj * 128 + n * 16) = v;
                        ssq += (v.x * v.x + v.y * v.y) + (v.z * v.z + v.w * v.w);
                        if (outb) { u32x2 w; w.x = cvt_pk_bf16(v.x, v.y); w.y = cvt_pk_bf16(v.z, v.w); *(u32x2*)(outb + (size_t)row * 1024 + col0 + bj * 128 + n * 16) = w; }
                    }
                ssq += __shfl_xor(ssq, 16); ssq += __shfl_xor(ssq, 32);
                if (fq == 0) ssout[(size_t)row * 16 + u.pn * 4 + wc] = ssq;
            }
    }
};

struct EpiZ {
    static constexpr bool PERM = true;
    bf16_t* Z; float* LA; const float* ss; const float* bgate;
    __device__ __forceinline__ void operator()(const AccT& acc, const Unit& u, int wr, int wc, int fr, int fq) const {
        const int row0 = u.pm * 256 + wr * 64 + fr, cw = wc * 32 + 8 * fq;
        const int pn = u.pn;
        const int zc0 = (pn < 6 ? pn : pn - 1) * 256;
        const int mode = (pn == 6) ? 3 : ((pn == 4 || pn == 5) ? 1 : (pn >= 9 ? 2 : 0));
#pragma unroll
        for (int ai = 0; ai < 2; ++ai)
#pragma unroll
            for (int m = 0; m < 4; ++m) {
                const int row = row0 + ai * 128 + m * 16;
                const float rs = row_rstd(ss, 16, row);
#pragma unroll
                for (int bj = 0; bj < 2; ++bj) {
                    float o[8];
#pragma unroll
                    for (int n = 0; n < 2; ++n)
#pragma unroll
                        for (int j = 0; j < 4; ++j) o[n * 4 + j] = acc[ai][bj][m][n][j] * rs;
                    const int c = bj * 128 + cw;
                    if (mode == 3) {
                        const f32x4 b0 = *(const f32x4*)(bgate + c), b1 = *(const f32x4*)(bgate + c + 4);
                        const float bb[8] = {b0.x, b0.y, b0.z, b0.w, b1.x, b1.y, b1.z, b1.w};
#pragma unroll
                        for (int i = 0; i < 8; ++i) { const float x = o[i] + bb[i]; o[i] = (fminf(x, 0.f) - __logf(1.0f + __expf(-fabsf(x)))) * (1.0f / 16.0f); }
                        float* lp = LA + (size_t)row * 256 + c;
                        *(f32x4*)lp = (f32x4){o[0], o[1], o[2], o[3]}; *(f32x4*)(lp + 4) = (f32x4){o[4], o[5], o[6], o[7]};
                    } else {
                        if (mode == 1) {
#pragma unroll
                            for (int i = 0; i < 8; ++i) o[i] = fsilu(o[i]);
                        } else if (mode == 2) {
#pragma unroll
                            for (int i = 0; i < 8; ++i) o[i] = fsigmoid(o[i]);
                        }
                        u32x4 w; w.x = cvt_pk_bf16(o[0], o[1]); w.y = cvt_pk_bf16(o[2], o[3]); w.z = cvt_pk_bf16(o[4], o[5]); w.w = cvt_pk_bf16(o[6], o[7]);
                        *(u32x4*)(Z + (size_t)row * LDZ + zc0 + c) = w;
                    }
                }
            }
    }
};

template <bool ADD> struct EpiMix {
    static constexpr bool PERM = true;
    bf16_t* T; const bf16_t* Z; int zoff;
    __device__ __forceinline__ void operator()(const AccT& acc, const Unit& u, int wr, int wc, int fr, int fq) const {
        const int row0 = u.pm * 256 + wr * 64 + fr, col0 = u.pn * 256 + wc * 32 + 8 * fq;
#pragma unroll
        for (int ai = 0; ai < 2; ++ai)
#pragma unroll
            for (int m = 0; m < 4; ++m) {
                const int row = row0 + ai * 128 + m * 16;
#pragma unroll
                for (int bj = 0; bj < 2; ++bj) {
                    const int col = col0 + bj * 128;
                    const u32x4 gw = *(const u32x4*)(Z + (size_t)row * LDZ + zoff + col);
                    float o[8];
                    o[0] = bflo(gw.x) * acc[ai][bj][m][0][0]; o[1] = bfhi(gw.x) * acc[ai][bj][m][0][1];
                    o[2] = bflo(gw.y) * acc[ai][bj][m][0][2]; o[3] = bfhi(gw.y) * acc[ai][bj][m][0][3];
                    o[4] = bflo(gw.z) * acc[ai][bj][m][1][0]; o[5] = bfhi(gw.z) * acc[ai][bj][m][1][1];
                    o[6] = bflo(gw.w) * acc[ai][bj][m][1][2]; o[7] = bfhi(gw.w) * acc[ai][bj][m][1][3];
                    bf16_t* tp = T + (size_t)row * 1024 + col;
                    if (ADD) { const u32x4 tw = *(const u32x4*)tp;
                        o[0] += bflo(tw.x); o[1] += bfhi(tw.x); o[2] += bflo(tw.y); o[3] += bfhi(tw.y);
                        o[4] += bflo(tw.z); o[5] += bfhi(tw.z); o[6] += bflo(tw.w); o[7] += bfhi(tw.w); }
                    u32x4 w; w.x = cvt_pk_bf16(o[0], o[1]); w.y = cvt_pk_bf16(o[2], o[3]); w.z = cvt_pk_bf16(o[4], o[5]); w.w = cvt_pk_bf16(o[6], o[7]);
                    *(u32x4*)tp = w;
                }
            }
    }
};

__device__ __forceinline__ void tr_item(const float* W, int ldw, int scol, int k0, const float* gain, bf16_t* WT, int ldt, int n_dst0, LAS float* scr, int lane) {
#pragma unroll 8
    for (int i = 0; i < 32; ++i) { const int kk = 2 * i + (lane >> 5); float v = W[(size_t)(k0 + kk) * ldw + scol + (lane & 31)]; if (gain) v *= gain[k0 + kk]; scr[kk * 33 + (lane & 31)] = v; }
    LDS_FENCE();
    const int c = lane & 7;
#pragma unroll
    for (int j = 0; j < 4; ++j) { const int n = (lane >> 3) + 8 * j; const LAS float* s = scr + (8 * c) * 33 + n;
        u32x4 o; o.x = cvt_pk_bf16(s[0 * 33], s[1 * 33]); o.y = cvt_pk_bf16(s[2 * 33], s[3 * 33]); o.z = cvt_pk_bf16(s[4 * 33], s[5 * 33]); o.w = cvt_pk_bf16(s[6 * 33], s[7 * 33]);
        *(u32x4*)(WT + (size_t)(n_dst0 + n) * ldt + k0 + 8 * c) = o; }
    LDS_FENCE();
}

__device__ __forceinline__ void p0_phase(const Params& P, LAS unsigned char* lds, const pg8::XMap& xm) {
    const int tid = threadIdx.x, lane = tid & 63, wave = tid >> 6;
    const int gw = blockIdx.x * 8 + wave, NGW = gridDim.x * 8;
    unsigned char* ws = P.ws;
    LAS float* scr = (LAS float*)lds + wave * (64 * 33);
    constexpr int I_GU = 16 * 176, I_D = 44 * 32, I_IN = 16 * 136, I_512 = 8 * 32, I_OUT = 16 * 32;
    constexpr int NIT = 2 * I_GU + 2 * I_D + I_IN + 3 * I_512 + I_OUT;
    if (wave < 7) for (int it = blockIdx.x * 7 + wave; it < NIT; it += gridDim.x * 7) {
        int r = it;
        if (r < 2 * I_GU) {
            const int l = r >= I_GU; r -= l * I_GU;
            const int kb = r / 176, nb = r % 176, n0 = nb * 32, pn = n0 >> 8, bj = (n0 >> 7) & 1, c = n0 & 127;
            const float* src = l ? (bj ? P.in[28] : P.in[27]) : (bj ? P.in[6] : P.in[5]);
            tr_item(src, FF, pn * 128 + c, kb * 64, l ? P.in[26] : P.in[4], (bf16_t*)(ws + (l ? WS_WGU2 : WS_WGU1)), 1024, n0, scr, lane);
            continue;
        }
        r -= 2 * I_GU;
        if (r < 2 * I_D) {
            const int l = r >= I_D; r -= l * I_D;
            const int kb = r / 32, nb = r % 32;
            tr_item(l ? P.in[29] : P.in[7], 1024, nb * 32, kb * 64, nullptr, (bf16_t*)(ws + (l ? WS_WD2 : WS_WD1)), FF, nb * 32, scr, lane);
            continue;
        }
        r -= 2 * I_D;
        if (r < I_IN) {
            const int kb = r / 136, nb = r % 136, n0 = nb * 32, k0 = kb * 64;
            bf16_t* WT = (bf16_t*)(ws + WS_WIN);
            if (n0 >= 1536 && n0 < 1792) {
                const int k = k0 + lane; const float gk = P.in[8][k];
                float a[16];
#pragma unroll
                for (int i = 0; i < 16; ++i) a[i] = gk * P.in[9][(size_t)k * 4112 + 1536 + i];
                const int j0 = n0 - 1536;
                for (int j = 0; j < 32; ++j) { float s = 0.f;
#pragma unroll
                    for (int i = 0; i < 16; ++i) s += a[i] * P.in[10][i * 256 + j0 + j];
                    WT[(size_t)(n0 + j) * 1024 + k] = f2bf(s); }
            } else {
                tr_item(P.in[9], 4112, n0 < 1536 ? n0 : n0 - 240, k0, P.in[8], WT, 1024, n0, scr, lane);
            }
            continue;
        }
        r -= I_IN;
        if (r < I_512) {
            const int kb = r / 32, nb = r % 32, n0 = nb * 32, pn = n0 >> 8, bj = (n0 >> 7) & 1, c = n0 & 127;
            tr_item(bj ? P.in[23] : P.in[22], 512, pn * 128 + c, kb * 64, nullptr, (bf16_t*)(ws + WS_WGLU), 512, n0, scr, lane);
            continue;
        }
        r -= I_512;
        if (r < 2 * I_512) {
            const int l = r >= I_512; r -= l * I_512;
            const int kb = r / 32, nb = r % 32;
            tr_item(l ? P.in[24] : P.in[13], 1024, nb * 32, kb * 64, nullptr, (bf16_t*)(ws + (l ? WS_WS5O : WS_WGO)), 512, nb * 32, scr, lane);
            continue;
        }
        r -= 2 * I_512;
        { const int kb = r / 32, nb = r % 32;
          tr_item(P.in[25], 1024, nb * 32, kb * 64, nullptr, (bf16_t*)(ws + WS_WOUT), 1024, nb * 32, scr, lane); }
    }
    bf16_t* XB = (bf16_t*)(ws + WS_RB); float* SSX = (float*)(ws + WS_SSX);
    for (int u = xm.rank * 8 + wave; u < pg8::xm_ntiles(xm, M / 256) * 256; u += xm.nb * 8) {
        const int row = (xm.xi + (u >> 8) * xm.nx) * 256 + (u & 255);
        const float* xr = row < MP ? P.in[0] + (size_t)row * 1024 : P.in[1] + (size_t)(row - MP) * 1024;
        f32x4 v[4]; float s = 0.f;
#pragma unroll
        for (int j = 0; j < 4; ++j) { v[j] = ((const f32x4*)xr)[lane + 64 * j]; s += (v[j].x * v[j].x + v[j].y * v[j].y) + (v[j].z * v[j].z + v[j].w * v[j].w); }
        s = wave_sum(s);
        if (lane == 0) SSX[row] = s;
#pragma unroll
        for (int j = 0; j < 4; ++j) { u32x2 w; w.x = cvt_pk_bf16(v[j].x, v[j].y); w.y = cvt_pk_bf16(v[j].z, v[j].w); ((u32x2*)(XB + (size_t)row * 1024))[lane + 64 * j] = w; }
    }
    const int gp = xm.rank * 512 + tid;
    unsigned char* tb = ws + WS_TBL + (size_t)xm.xi * TBL_STRIDE;
    for (int gp0 = gp; gp0 < 2048; gp0 += xm.nb * 512) { const int gp = gp0;
        const int g = gp >> 6, p = gp & 63;
        const float lr = P.in[14][gp], li = P.in[15][gp], dt = expf(P.in[16][g]);
        const float mag = expf(lr * dt); float ar = mag * cosf(li * dt), ai = mag * sinf(li * dt);
        const float nr = ar - 1.0f, ni = ai, den = lr * lr + li * li;
        const float fre = (nr * lr + ni * li) / den, fim = (ni * lr - nr * li) / den;
        bf16_t* BB = (bf16_t*)(tb + T_BB); bf16_t* CC = (bf16_t*)(tb + T_CC);
        for (int h = 0; h < 16; ++h) { const float br = P.in[17][gp * 16 + h], bi = P.in[18][gp * 16 + h];
            BB[(g * 128 + p) * 32 + h] = f2bf(fre * br - fim * bi); BB[(g * 128 + 64 + p) * 32 + h] = f2bf(fre * bi + fim * br);
            BB[(g * 128 + p) * 32 + 16 + h] = 0; BB[(g * 128 + 64 + p) * 32 + 16 + h] = 0; }
        for (int j = 0; j < 16; ++j) { CC[(g * 16 + j) * 128 + p] = f2bf(P.in[19][(g * 16 + j) * 64 + p]); CC[(g * 16 + j) * 128 + 64 + p] = f2bf(-P.in[20][(g * 16 + j) * 64 + p]); }
        float* AB = (float*)(tb + T_ABAR); AB[gp * 2] = ar; AB[gp * 2 + 1] = ai;
#pragma unroll
        for (int i = 0; i < 6; ++i) { const float t = ar * ar - ai * ai; ai = 2.0f * ar * ai; ar = t; }
        float* AB64 = (float*)(tb + T_ABAR64); AB64[gp * 2] = ar; AB64[gp * 2 + 1] = ai;
    }
}

__device__ __forceinline__ void gla_cumsum(const float* LA, int row0, int h, int w, int lane, LAS float* tot, float (&b)[8], float& blast) {
    float run = 0.f;
#pragma unroll
    for (int i = 0; i < 8; ++i) { run += LA[(size_t)(row0 + 8 * w + i) * 256 + h * 64 + lane]; b[i] = run; }
    tot[w * 64 + lane] = run;
    __syncthreads();
    float off = 0.f, all = 0.f;
#pragma unroll
    for (int ww = 0; ww < 8; ++ww) { const float tv = tot[ww * 64 + lane]; all += tv; if (ww < w) off += tv; }
#pragma unroll
    for (int i = 0; i < 8; ++i) b[i] += off;
    blast = all;
}

constexpr int LP = 72;
constexpr int L_QS = 0, L_KS = L_QS + 64 * LP * 2, L_VT = L_KS + 64 * LP * 2, L_ST = L_VT + 128 * LP * 2, L_PS = L_ST + 128 * LP * 2, L_TOT = L_PS  , L_SSQ = L_KS  , L_GLA_END = L_PS + 64 * LP * 2;
static_assert(L_GLA_END <= 65536, "GLA LDS must stay below 64 KiB");

__device__ __forceinline__ void gla_local(const Params& P, LAS unsigned char* lds, int c, int h) {
    const int tid = threadIdx.x, lane = tid & 63, w = tid >> 6, r = lane & 15, q = lane >> 4;
    unsigned char* ws = P.ws;
    const bf16_t* Z = (const bf16_t*)(ws + WS_Z); const float* LA = (const float*)(ws + WS_LA);
    LAS bf16_t* Kt = (LAS bf16_t*)(lds + L_KS); LAS bf16_t* Vt = (LAS bf16_t*)(lds + L_VT); LAS float* tot = (LAS float*)(lds + L_TOT);
    const int row0 = c * 64;
    float b[8], blast;
    gla_cumsum(LA, row0, h, w, lane, tot, b, blast);
    { float kh[8];
#pragma unroll
      for (int i = 0; i < 8; ++i) kh[i] = bf2f(Z[(size_t)(row0 + 8 * w + i) * LDZ + ZK + h * 64 + lane]) * __expf(blast - b[i]);
      u32x4 o; o.x = cvt_pk_bf16(kh[0], kh[1]); o.y = cvt_pk_bf16(kh[2], kh[3]); o.z = cvt_pk_bf16(kh[4], kh[5]); o.w = cvt_pk_bf16(kh[6], kh[7]);
      *(LAS u32x4*)(Kt + lane * LP + 8 * w) = o; }
#pragma unroll
    for (int half = 0; half < 2; ++half) { unsigned vv[8];
#pragma unroll
        for (int i = 0; i < 8; ++i) vv[i] = Z[(size_t)(row0 + 8 * w + i) * LDZ + ZV + h * 128 + half * 64 + lane];
        u32x4 o; o.x = vv[0] | (vv[1] << 16); o.y = vv[2] | (vv[3] << 16); o.z = vv[4] | (vv[5] << 16); o.w = vv[6] | (vv[7] << 16);
        *(LAS u32x4*)(Vt + (half * 64 + lane) * LP + 8 * w) = o; }
    if (w == 7) ((float*)(ws + WS_DEC))[(c * 4 + h) * 64 + lane] = __expf(blast);
    __syncthreads();
    bf16_t* DS = (bf16_t*)(ws + WS_R2) + (size_t)(c * 4 + h) * 8192;
    const int dkt = w & 3;
    bf16x8 a0 = *(const LAS bf16x8*)(Kt + (dkt * 16 + r) * LP + 8 * q), a1 = *(const LAS bf16x8*)(Kt + (dkt * 16 + r) * LP + 32 + 8 * q);
#pragma unroll
    for (int n = 0; n < 4; ++n) { const int dvt = (w >> 2) * 4 + n;
        f32x4 acc = {0.f, 0.f, 0.f, 0.f};
        acc = mfma_safe(a0, *(const LAS bf16x8*)(Vt + (dvt * 16 + r) * LP + 8 * q), acc);
        acc = mfma_safe(a1, *(const LAS bf16x8*)(Vt + (dvt * 16 + r) * LP + 32 + 8 * q), acc);
#pragma unroll
        for (int j = 0; j < 4; ++j) DS[(dkt * 16 + 4 * q + j) * 128 + dvt * 16 + r] = f2bf(acc[j]); }
    __syncthreads();
}

__device__ __forceinline__ void gla_out(const Params& P, LAS unsigned char* lds, int c, int h) {
    const int tid = threadIdx.x, lane = tid & 63, w = tid >> 6, r = lane & 15, q = lane >> 4;
    unsigned char* ws = P.ws;
    const bf16_t* Z = (const bf16_t*)(ws + WS_Z); const float* LA = (const float*)(ws + WS_LA);
    LAS bf16_t* Qs = (LAS bf16_t*)(lds + L_QS); LAS bf16_t* Ks = (LAS bf16_t*)(lds + L_KS); LAS bf16_t* Vt = (LAS bf16_t*)(lds + L_VT);
    LAS bf16_t* St = (LAS bf16_t*)(lds + L_ST); LAS bf16_t* Ps = (LAS bf16_t*)(lds + L_PS); LAS float* tot = (LAS float*)(lds + L_TOT); LAS float* ssq = (LAS float*)(lds + L_SSQ);
    const int row0 = c * 64;
    float b[8], blast;
    gla_cumsum(LA, row0, h, w, lane, tot, b, blast);
#pragma unroll
    for (int i = 0; i < 8; ++i) { const int t = 8 * w + i; const size_t zr = (size_t)(row0 + t) * LDZ;
        const float e = __expf(b[i]);
        Qs[t * LP + lane] = f2bf(bf2f(Z[zr + ZQ + h * 64 + lane]) * e * 0.125f);
        Ks[t * LP + lane] = f2bf(bf2f(Z[zr + ZK + h * 64 + lane]) * __builtin_amdgcn_rcpf(e)); }
#pragma unroll
    for (int half = 0; half < 2; ++half) { unsigned vv[8];
#pragma unroll
        for (int i = 0; i < 8; ++i) vv[i] = Z[(size_t)(row0 + 8 * w + i) * LDZ + ZV + h * 128 + half * 64 + lane];
        u32x4 o; o.x = vv[0] | (vv[1] << 16); o.y = vv[2] | (vv[3] << 16); o.z = vv[4] | (vv[5] << 16); o.w = vv[6] | (vv[7] << 16);
        *(LAS u32x4*)(Vt + (half * 64 + lane) * LP + 8 * w) = o; }
    if (c < 512) { const bf16_t* Sp = (const bf16_t*)(ws + WS_SPB) + (size_t)(c * 4 + h) * 8192;
#pragma unroll
      for (int half = 0; half < 2; ++half) { unsigned vv[8];
#pragma unroll
        for (int i = 0; i < 8; ++i) vv[i] = Sp[(8 * w + i) * 128 + half * 64 + lane];
        u32x4 o; o.x = vv[0] | (vv[1] << 16); o.y = vv[2] | (vv[3] << 16); o.z = vv[4] | (vv[5] << 16); o.w = vv[6] | (vv[7] << 16);
        *(LAS u32x4*)(St + (half * 64 + lane) * LP + 8 * w) = o; }
    } else { const float* Sp = P.in[2] + (size_t)((c - 512) * 4 + h) * 8192;
#pragma unroll
      for (int half = 0; half < 2; ++half) { float sv[8];
#pragma unroll
        for (int i = 0; i < 8; ++i) sv[i] = Sp[(8 * w + i) * 128 + half * 64 + lane];
        u32x4 o; o.x = cvt_pk_bf16(sv[0], sv[1]); o.y = cvt_pk_bf16(sv[2], sv[3]); o.z = cvt_pk_bf16(sv[4], sv[5]); o.w = cvt_pk_bf16(sv[6], sv[7]);
        *(LAS u32x4*)(St + (half * 64 + lane) * LP + 8 * w) = o; } }
    __syncthreads();
#pragma unroll
    for (int i = 0; i < 2; ++i) { const int tile = w * 2 + i, tt = tile >> 2, st = tile & 3;
        f32x4 acc = {0.f, 0.f, 0.f, 0.f};
        if (st <= tt) {
#pragma unroll
            for (int k0 = 0; k0 < 64; k0 += 32)
                acc = mfma_safe(*(const LAS bf16x8*)(Qs + (tt * 16 + r) * LP + k0 + 8 * q), *(const LAS bf16x8*)(Ks + (st * 16 + r) * LP + k0 + 8 * q), acc);
        }
#pragma unroll
        for (int j = 0; j < 4; ++j) { const int t = tt * 16 + 4 * q + j, s = st * 16 + r; Ps[t * LP + s] = f2bf(s <= t ? acc[j] : 0.f); } }
    __syncthreads();
    const int tt = w >> 1, dh = w & 1;
    f32x4 oa[4];
#pragma unroll
    for (int n = 0; n < 4; ++n) oa[n] = (f32x4){0.f, 0.f, 0.f, 0.f};
#pragma unroll
    for (int k0 = 0; k0 < 64; k0 += 32) {
        const bf16x8 pa = *(const LAS bf16x8*)(Ps + (tt * 16 + r) * LP + k0 + 8 * q), qa = *(const LAS bf16x8*)(Qs + (tt * 16 + r) * LP + k0 + 8 * q);
#pragma unroll
        for (int n = 0; n < 4; ++n) { const int dv0 = (dh * 4 + n) * 16;
            oa[n] = mfma_safe(pa, *(const LAS bf16x8*)(Vt + (dv0 + r) * LP + k0 + 8 * q), oa[n]);
            oa[n] = mfma_safe(qa, *(const LAS bf16x8*)(St + (dv0 + r) * LP + k0 + 8 * q), oa[n]); }
    }
    float sq[4];
#pragma unroll
    for (int j = 0; j < 4; ++j) { float s = 0.f;
#pragma unroll
        for (int n = 0; n < 4; ++n) s += oa[n][j] * oa[n][j];
        s += __shfl_xor(s, 1); s += __shfl_xor(s, 2); s += __shfl_xor(s, 4); s += __shfl_xor(s, 8);
        sq[j] = s; }
    if (r == 0) {
#pragma unroll
        for (int j = 0; j < 4; ++j) ssq[(tt * 16 + 4 * q + j) * 2 + dh] = sq[j]; }
    __syncthreads();
    bf16_t* OG = (bf16_t*)(ws + WS_RB);
#pragma unroll
    for (int j = 0; j < 4; ++j) { const int t = tt * 16 + 4 * q + j; const size_t row = (size_t)(row0 + t);
        const float rs = rsqrtf((ssq[t * 2] + ssq[t * 2 + 1]) * (1.0f / 128.0f) + EPS);
#pragma unroll
        for (int n = 0; n < 4; ++n) { const int col = h * 128 + (dh * 4 + n) * 16 + r;
            OG[row * 512 + col] = f2bf(oa[n][j] * rs * P.in[12][col] * bf2f(Z[row * LDZ + ZR + col])); } }
    __syncthreads();
}

constexpr int S5_WAVE_LDS = 16384, S5_X_OFF = 8192, XP = 136;
template <bool FULL>
__device__ __forceinline__ void s5_wave(const Params& P, const unsigned char* tb, LAS unsigned char* wl, const pg8::XMap& xm, int NTX, int wave, int lane) {
    unsigned char* ws = P.ws;
    const int r = lane & 15, q = lane >> 4;
    const bf16_t* Z = (const bf16_t*)(ws + WS_Z);
    const bf16_t* BB = (const bf16_t*)(tb + T_BB); const bf16_t* CC = (const bf16_t*)(tb + T_CC);
    LAS float* BU = (LAS float*)wl; LAS bf16_t* X = (LAS bf16_t*)(wl + S5_X_OFF);
    bf16_t* G5 = (bf16_t*)(ws + WS_RB) + (size_t)M * 512;
    const int ustep = xm.nb * S5_NW, uend = NTX * 128;
    int gcur = -1; float ar = 0.f, ai = 0.f, dsk = 0.f;
    bf16x8 bb[8], cc[4], an[4]; unsigned uvn[4][4]; float x0r = 0.f, x0i = 0.f;
#define S5_C(uu) ((xm.xi + ((uu) >> 7) * xm.nx) * 4 + (((uu) >> 5) & 3))
#define S5_FETCH(uu) do { const int c_ = S5_C(uu), g_ = (uu) & 31, row0_ = c_ * 64; \
        _Pragma("unroll") for (int sb = 0; sb < 4; ++sb) { an[sb] = *(const bf16x8*)(Z + (size_t)(row0_ + sb * 16 + r) * LDZ + ZU + g_ * 16 + 8 * (q & 1)); \
            if (FULL) { _Pragma("unroll") for (int j = 0; j < 4; ++j) uvn[sb][j] = Z[(size_t)(row0_ + sb * 16 + 4 * q + j) * LDZ + ZU + g_ * 16 + r]; } } \
        if (FULL) { const float* x0 = (c_ < 512) ? (const float*)(ws + WS_XP) + ((size_t)(c_ * 32 + g_) * 64 + lane) * 2 : P.in[3] + ((size_t)((c_ - 512) * 32 + g_) * 64 + lane) * 2; \
            x0r = x0[0]; x0i = x0[1]; } } while (0)
    int u = xm.rank * S5_NW + wave;
    if (u < uend) S5_FETCH(u);
    for (; u < uend; u += ustep) {
        const int c = S5_C(u), g = u & 31, row0 = c * 64;
        bf16x8 a[4]; unsigned uv[4][4]; float xr = FULL ? x0r : 0.f, xi = FULL ? x0i : 0.f;
#pragma unroll
        for (int sb = 0; sb < 4; ++sb) { a[sb] = an[sb];
#pragma unroll
            for (int j = 0; j < 4; ++j) uv[sb][j] = FULL ? uvn[sb][j] : 0u; }
        if (u + ustep < uend) S5_FETCH(u + ustep);
        if (!FULL && c >= 512) continue;
        if (g != gcur) { gcur = g;
            ar = ((const float*)(tb + T_ABAR))[(g * 64 + lane) * 2]; ai = ((const float*)(tb + T_ABAR))[(g * 64 + lane) * 2 + 1];
#pragma unroll
            for (int n = 0; n < 8; ++n) bb[n] = *(const bf16x8*)(BB + (g * 128 + n * 16 + r) * 32 + 8 * q);
            if (FULL) { dsk = P.in[21][g * 16 + r];
#pragma unroll
                for (int kk = 0; kk < 4; ++kk) cc[kk] = *(const bf16x8*)(CC + (g * 16 + r) * 128 + kk * 32 + 8 * q); } }
#pragma unroll
        for (int sb = 0; sb < 4; ++sb) {
#pragma unroll
            for (int n = 0; n < 8; ++n) {
                f32x4 acc = {0.f, 0.f, 0.f, 0.f};
                acc = mfma_safe(a[sb], bb[n], acc);
#pragma unroll
                for (int j = 0; j < 4; ++j) BU[(4 * q + j) * 128 + n * 16 + r] = acc[j];
            }
            LDS_FENCE();
#pragma unroll 4
            for (int t = 0; t < 16; ++t) {
                const float br = BU[t * 128 + lane], bi = BU[t * 128 + 64 + lane];
                const float nxr = ar * xr - ai * xi + br, nxi = ar * xi + ai * xr + bi;
                xr = nxr; xi = nxi;
                if (FULL) { X[t * XP + lane] = f2bf(xr); X[t * XP + 64 + lane] = f2bf(xi); }
            }
            LDS_FENCE();
            if (FULL) {
                f32x4 y = {0.f, 0.f, 0.f, 0.f};
#pragma unroll
                for (int kk = 0; kk < 4; ++kk) y = mfma_safe(*(const LAS bf16x8*)(X + r * XP + kk * 32 + 8 * q), cc[kk], y);
#pragma unroll
                for (int j = 0; j < 4; ++j) { const size_t row = (size_t)(row0 + sb * 16 + 4 * q + j);
                    const float yv = y[j] + dsk * bf2f((bf16_t)uv[sb][j]);
                    const float gl = yv * fsigmoid(1.5957691216f * (yv + 0.044715f * yv * yv * yv));
                    G5[row * 512 + g * 16 + r] = f2bf(gl); }
                LDS_FENCE();
            }
        }
        if (!FULL) { float* E = (float*)(ws + WS_E) + ((size_t)(c * 32 + g) * 64 + lane) * 2; E[0] = xr; E[1] = xi; }
        else if (c >= 512) { float* o = P.out + O_S5S + ((size_t)((c - 512) * 32 + g) * 64 + lane) * 2; o[0] = xr; o[1] = xi; }
    }
#undef S5_C
#undef S5_FETCH
}

__device__ __forceinline__ void carry_phase(const Params& P, const unsigned char* tb) {
    unsigned char* ws = P.ws;
    const int gid = blockIdx.x * 512 + threadIdx.x, NT = gridDim.x * 512;
    const bf16_t* DS = (const bf16_t*)(ws + WS_R2); bf16_t* SPB = (bf16_t*)(ws + WS_SPB); const float* DEC = (const float*)(ws + WS_DEC);
    for (int e = gid; e < 65536; e += NT) {
        const int bh = e >> 13, el = e & 8191, dk = el >> 7, bb = bh >> 2, h = bh & 3;
        float S = 0.f;
        for (int c = 0; c < 256; c += 8) {
            float v[8], d[8];
#pragma unroll
            for (int i = 0; i < 8; ++i) { const int ch = bb * 256 + c + i; v[i] = bf2f(DS[(size_t)(ch * 4 + h) * 8192 + el]); d[i] = DEC[(ch * 4 + h) * 64 + dk]; }
#pragma unroll
            for (int i = 0; i < 8; ++i) { const int ch = bb * 256 + c + i; SPB[(size_t)(ch * 4 + h) * 8192 + el] = f2bf(S); S = d[i] * S + v[i]; }
        }
        P.out[O_GLAP + e] = S;
    }
    for (int e = gid; e < 524288; e += NT) {
        const int sh = e >> 13, el = e & 8191, dk = el >> 7, ch = 512 * 4 + sh;
        P.out[O_GLAS + e] = DEC[ch * 64 + dk] * P.in[2][e] + bf2f(DS[(size_t)ch * 8192 + el]);
    }
    for (int e = gid; e < 4096; e += NT) {
        const int bb = e >> 11, gp = e & 2047;
        const float ar = ((const float*)(tb + T_ABAR64))[gp * 2], ai = ((const float*)(tb + T_ABAR64))[gp * 2 + 1];
        const f32x2* E = (const f32x2*)(ws + WS_E); f32x2* XPv = (f32x2*)(ws + WS_XP);
        float xr = 0.f, xi = 0.f;
        for (int c = 0; c < 256; c += 8) {
            f32x2 v[8];
#pragma unroll
            for (int i = 0; i < 8; ++i) v[i] = E[(size_t)(bb * 256 + c + i) * 2048 + gp];
#pragma unroll
            for (int i = 0; i < 8; ++i) { XPv[(size_t)(bb * 256 + c + i) * 2048 + gp] = (f32x2){xr, xi};
                const float nxr = ar * xr - ai * xi + v[i].x, nxi = ar * xi + ai * xr + v[i].y; xr = nxr; xi = nxi; }
        }
        P.out[O_S5P + (size_t)e * 2] = xr; P.out[O_S5P + (size_t)e * 2 + 1] = xi;
    }
}

__global__ void __launch_bounds__(512, 2) fwd_kernel(Params P) {
    extern __shared__ __attribute__((aligned(16))) unsigned char smem[];
    LAS unsigned char* lds = (LAS unsigned char*)smem;
    cg::grid_group grid = cg::this_grid();
    unsigned char* ws = P.ws;
    const int lo = P.ph_lo, hi = P.ph_hi;
    const int G = gridDim.x, bx = blockIdx.x;
    const int tid = threadIdx.x, lane = tid & 63, wave = tid >> 6;
#define IN(k) (lo <= (k) && (k) < hi)
#define SEAM(k) do { if (IN(k) && IN((k) + 1)) { asm volatile("s_waitcnt vmcnt(0)" ::: "memory"); __syncthreads(); grid.sync(); \
        __builtin_amdgcn_fence(__ATOMIC_ACQUIRE, "agent"); asm volatile("s_waitcnt vmcnt(0)" ::: "memory"); __syncthreads(); } } while (0)
    float* Y = P.out + O_Y;
    bf16_t* RB = (bf16_t*)(ws + WS_RB); bf16_t* ZB = (bf16_t*)(ws + WS_Z); bf16_t* ACT = ZB; bf16_t* GLU = (bf16_t*)(ws + WS_LA); bf16_t* TM = (bf16_t*)(ws + WS_R2);
    float* LA = (float*)(ws + WS_LA);
    float* SSX = (float*)(ws + WS_SSX); float* SSH = (float*)(ws + WS_SSH); float* SS2 = (float*)(ws + WS_SS2); float* SS3 = (float*)(ws + WS_SS3);

    pg8::XMap xm;
    {
        unsigned* ctl = (unsigned*)(ws + WS_CTL) + 64 * (hi - lo == N_PHASES ? 0 : 1 + lo);
        LAS unsigned* lw = (LAS unsigned*)(lds + LDS_BYTES - 16);
        const unsigned xcc = (unsigned)__builtin_amdgcn_s_getreg((3 << 11) | 20) & 0xFu;
        if (tid == 0) { lw[0] = __hip_atomic_fetch_add(ctl + xcc, 1u, RLX_AGENT); lw[1] = xcc; }
        asm volatile("s_waitcnt vmcnt(0)" ::: "memory"); __syncthreads(); grid.sync(); __syncthreads();
        int nx = 0, xi = 0;
        for (int j = 0; j < 16; ++j) { const unsigned cj = __hip_atomic_load(ctl + j, RLX_AGENT); if (cj) { if (j < (int)lw[1]) ++xi; ++nx; } }
        xm.nx = nx; xm.xi = xi; xm.rank = (int)lw[0]; xm.nb = (int)__hip_atomic_load(ctl + lw[1], RLX_AGENT);
        __syncthreads();
    }
    const int NTX = pg8::xm_ntiles(xm, M / 256);
    if (IN(0)) p0_phase(P, lds, xm);
    SEAM(0);
    if (IN(1)) { pg8::Gemm g{RB, (const bf16_t*)(ws + WS_WGU1), M, 5632, 1024}; pg8::XcdOrder S; S.init(M, 5632, xm);
        EpiGated<false> E{ACT, FF, SSX, 1}; pg8::gemm_phase(lds, g, S, E); }
    SEAM(1);
    if (IN(2)) { pg8::Gemm g{ACT, (const bf16_t*)(ws + WS_WD1), M, 1024, FF}; pg8::XcdOrder S; S.init(M, 1024, xm);
        EpiRes E{P.in[0], P.in[1], Y, RB, SSH, 0.5f}; pg8::gemm_phase(lds, g, S, E); }
    SEAM(2);
    if (IN(3)) { pg8::Gemm g{RB, (const bf16_t*)(ws + WS_WIN), M, NZ, 1024}; pg8::XcdOrder S; S.init(M, NZ, xm);
        EpiZ E{ZB, LA, SSH, P.in[11]}; pg8::gemm_phase(lds, g, S, E); }
    SEAM(3);
    for (int rep = 0; rep < TIMING_REP_MIXER; ++rep) {
    if (IN(4)) {
        for (int u = xm.rank; u < NTX * 16; u += xm.nb) gla_local(P, lds, (xm.xi + (u >> 4) * xm.nx) * 4 + ((u >> 2) & 3), u & 3);
        if (wave < S5_NW) s5_wave<false>(P, ws + WS_TBL + (size_t)xm.xi * TBL_STRIDE, lds + wave * S5_WAVE_LDS, xm, NTX, wave, lane);
    }
    SEAM(4);
    if (IN(5)) carry_phase(P, ws + WS_TBL + (size_t)xm.xi * TBL_STRIDE);
    SEAM(5);
    if (IN(6)) {
        for (int u = xm.rank; u < NTX * 16; u += xm.nb) gla_out(P, lds, (xm.xi + (u >> 4) * xm.nx) * 4 + ((u >> 2) & 3), u & 3);
        if (wave < S5_NW) s5_wave<true>(P, ws + WS_TBL + (size_t)xm.xi * TBL_STRIDE, lds + wave * S5_WAVE_LDS, xm, NTX, wave, lane);
        __syncthreads();
    }
    SEAM(6);
    }
    if (IN(7)) {
        { pg8::Gemm g{RB + (size_t)M * 512, (const bf16_t*)(ws + WS_WGLU), M, 1024, 512}; pg8::XcdOrder S; S.init(M, 1024, xm);
          EpiGated<true> E{GLU, 512, nullptr, 0}; pg8::gemm_phase(lds, g, S, E); }
        { pg8::Gemm g{RB, (const bf16_t*)(ws + WS_WGO), M, 1024, 512}; pg8::XcdOrder S; S.init(M, 1024, xm);
          EpiMix<false> E{TM, ZB, ZGG}; pg8::gemm_phase(lds, g, S, E); }
    }
    SEAM(7);
    if (IN(8)) { pg8::Gemm g{GLU, (const bf16_t*)(ws + WS_WS5O), M, 1024, 512}; pg8::XcdOrder S; S.init(M, 1024, xm);
        EpiMix<true> E{TM, ZB, ZG5}; pg8::gemm_phase(lds, g, S, E); }
    SEAM(8);
    if (IN(9)) { pg8::Gemm g{TM, (const bf16_t*)(ws + WS_WOUT), M, 1024, 1024}; pg8::XcdOrder S; S.init(M, 1024, xm);
        EpiRes E{Y, Y + (size_t)MP * 1024, Y, RB, SS2, 1.0f}; pg8::gemm_phase(lds, g, S, E); }
    SEAM(9);
    if (IN(10)) { pg8::Gemm g{RB, (const bf16_t*)(ws + WS_WGU2), M, 5632, 1024}; pg8::XcdOrder S; S.init(M, 5632, xm);
        EpiGated<false> E{ACT, FF, SS2, 16}; pg8::gemm_phase(lds, g, S, E); }
    SEAM(10);
    if (IN(11)) { pg8::Gemm g{ACT, (const bf16_t*)(ws + WS_WD2), M, 1024, FF}; pg8::XcdOrder S; S.init(M, 1024, xm);
        EpiRes E{Y, Y + (size_t)MP * 1024, Y, nullptr, SS3, 0.5f}; pg8::gemm_phase(lds, g, S, E); }
    SEAM(11);
    if (IN(12)) {
        const float* gf = P.in[30];
        for (int u = xm.rank * 8 + wave; u < NTX * 256; u += xm.nb * 8) {
            const int row = (xm.xi + (u >> 8) * xm.nx) * 256 + (u & 255);
            const float rs = row_rstd(SS3, 16, row);
            f32x4* yr = (f32x4*)(Y + (size_t)row * 1024);
#pragma unroll
            for (int j = 0; j < 4; ++j) { const f32x4 v = yr[lane + 64 * j], gg = ((const f32x4*)gf)[lane + 64 * j]; yr[lane + 64 * j] = v * rs * gg; }
        }
        asm volatile("s_waitcnt vmcnt(0)" ::: "memory"); __threadfence_system(); asm volatile("s_waitcnt vmcnt(0)" ::: "memory");
    }
}

extern "C" void kernel_launch(void* const* d_in, const int* in_sizes, int n_in, void* d_out, int out_size, void* d_ws, size_t ws_size, hipStream_t stream) {
    static int grid_blocks = 0;
    if (grid_blocks == 0) {
        if (n_in != 31 || ws_size < WS_END) { fprintf(stderr, "kernel_launch: need 31 inputs and >= %zu bytes of workspace; got %d, %zu\n", (size_t)WS_END, n_in, ws_size); grid_blocks = -1; return; }
        int dev = 0, cus = 0, per_cu = 0;
        hipGetDevice(&dev);
        hipDeviceGetAttribute(&cus, hipDeviceAttributeMultiprocessorCount, dev);
        if (hipFuncSetAttribute((const void*)fwd_kernel, hipFuncAttributeMaxDynamicSharedMemorySize, LDS_BYTES) != hipSuccess) { fprintf(stderr, "kernel_launch: hipFuncSetAttribute failed\n"); grid_blocks = -1; return; }
        if (hipOccupancyMaxActiveBlocksPerMultiprocessor(&per_cu, (const void*)fwd_kernel, 512, LDS_BYTES) != hipSuccess || per_cu < 1) { fprintf(stderr, "kernel_launch: occupancy query gave %d\n", per_cu); per_cu = 1; }
        (void)hipGetLastError();
        grid_blocks = cus * 1;
        fprintf(stderr, "kernel_launch: cus %d per_cu %d grid %d\n", cus, per_cu, grid_blocks);
    }
    if (grid_blocks < 0) return;
    hipMemsetAsync((unsigned char*)d_ws + WS_CTL, 0, 8192, stream);
    Params p{};
    for (int i = 0; i < 31; ++i) p.in[i] = (const float*)d_in[i];
    p.out = (float*)d_out; p.ws = (unsigned char*)d_ws;
    p.ph_lo = 0; p.ph_hi = N_PHASES;
    void* args[] = {&p};
    hipError_t e = hipLaunchCooperativeKernel((const void*)fwd_kernel, dim3(grid_blocks), dim3(512), args, LDS_BYTES, stream);
    if (e != hipSuccess) fprintf(stderr, "cooperative launch failed: %s (grid %d)\n", hipGetErrorString(e), grid_blocks);
}
```

```cpp
#include <hip/hip_runtime.h>
#include <hip/hip_cooperative_groups.h>
#include <cstdio>
#include <cstdint>
namespace cg = cooperative_groups;


#define LAS __attribute__((address_space(3)))
typedef unsigned short bf16_t;
typedef short bf16x8 __attribute__((ext_vector_type(8)));
typedef float f32x4 __attribute__((ext_vector_type(4)));
typedef float f32x2 __attribute__((ext_vector_type(2)));
typedef unsigned u32x4 __attribute__((ext_vector_type(4)));
typedef unsigned u32x2 __attribute__((ext_vector_type(2)));

constexpr int MP = 32768;
constexpr int MS = 1024;
constexpr int M = MP + MS;
constexpr int D = 1024, FF = 2816;
constexpr int NZ = 4352;
constexpr int LDZ = 4096;
constexpr int ZQ = 0, ZK = 256, ZV = 512, ZR = 1024, ZU = 1536, ZGG = 2048, ZG5 = 3072;
constexpr int NCH = 528;
constexpr float EPS = 1e-6f;

constexpr size_t SZ_WGU = (size_t)5632 * 1024 * 2, SZ_WD = (size_t)1024 * 2816 * 2, SZ_WIN = (size_t)NZ * 1024 * 2;
constexpr size_t SZ_W512 = (size_t)1024 * 512 * 2, SZ_WOUT = (size_t)1024 * 1024 * 2;
constexpr size_t WS_WGU1 = 0;
constexpr size_t WS_WD1 = WS_WGU1 + SZ_WGU;
constexpr size_t WS_WIN = WS_WD1 + SZ_WD;
constexpr size_t WS_WGLU = WS_WIN + SZ_WIN;
constexpr size_t WS_WGO = WS_WGLU + SZ_W512;
constexpr size_t WS_WS5O = WS_WGO + SZ_W512;
constexpr size_t WS_WOUT = WS_WS5O + SZ_W512;
constexpr size_t WS_WGU2 = WS_WOUT + SZ_WOUT;
constexpr size_t WS_WD2 = WS_WGU2 + SZ_WGU;
constexpr size_t WS_RB = WS_WD2 + SZ_WD;
constexpr size_t SZ_RB = (size_t)M * 1024 * 2;
constexpr size_t WS_Z = WS_RB + SZ_RB;
constexpr size_t SZ_Z = (size_t)M * LDZ * 2;
constexpr size_t WS_LA = WS_Z + SZ_Z;
constexpr size_t SZ_LA = (size_t)M * 256 * 4;
constexpr size_t WS_R2 = WS_LA + SZ_LA;
constexpr size_t WS_SPB = WS_R2 + (size_t)NCH * 4 * 8192 * 2;
constexpr size_t SZ_R2 = (size_t)M * 1024 * 2;
constexpr size_t WS_SSX = WS_R2 + SZ_R2;
constexpr size_t WS_SSH = WS_SSX + (size_t)M * 4;
constexpr size_t WS_SS2 = WS_SSH + (size_t)M * 64;
constexpr size_t WS_SS3 = WS_SS2 + (size_t)M * 64;
constexpr size_t WS_DEC = WS_SS3 + (size_t)M * 64;
constexpr size_t WS_E = WS_DEC + (size_t)NCH * 4 * 64 * 4;
constexpr size_t WS_TBL = WS_E + (size_t)512 * 32 * 64 * 2 * 4;
constexpr size_t T_ABAR = 0, T_ABAR64 = 16384, T_BB = 32768, T_CC = T_BB + 262144, TBL_STRIDE = T_CC + 131072;
constexpr size_t WS_CC_END = WS_TBL + 16 * TBL_STRIDE;
constexpr size_t WS_XP = WS_CC_END;
constexpr size_t WS_CTL = WS_XP + (size_t)512 * 32 * 64 * 2 * 4;
constexpr size_t WS_END = WS_CTL + 8192;

constexpr size_t O_Y = 0, O_GLAP = (size_t)M * 1024, O_S5P = O_GLAP + 65536, O_GLAS = O_S5P + 8192, O_S5S = O_GLAS + 524288;

constexpr int LDS_BYTES = 147456;
constexpr int N_PHASES = 13;
#ifndef TIMING_REP_MIXER
#define TIMING_REP_MIXER 1
#endif
constexpr int S5_NW = 4;

struct Params {
    const float* in[31];
    float* out;
    unsigned char* ws;
    int ph_lo, ph_hi;
};

__device__ __forceinline__ unsigned cvt_pk_bf16(float lo, float hi) { unsigned r; asm volatile("v_cvt_pk_bf16_f32 %0, %1, %2" : "=v"(r) : "v"(lo), "v"(hi)); return r; }
__device__ __forceinline__ bf16_t f2bf(float f) { return (bf16_t)(cvt_pk_bf16(f, 0.f) & 0xffffu); }
__device__ __forceinline__ float bf2f(bf16_t b) { return __uint_as_float(((unsigned)b) << 16); }
__device__ __forceinline__ float bflo(unsigned w) { return __uint_as_float(w << 16); }
__device__ __forceinline__ float bfhi(unsigned w) { return __uint_as_float(w & 0xffff0000u); }
__device__ __forceinline__ float fsigmoid(float x) { return __builtin_amdgcn_rcpf(1.0f + __expf(-x)); }
__device__ __forceinline__ float fsilu(float x) { return x * fsigmoid(x); }
__device__ __forceinline__ float wave_sum(float v) {
#pragma unroll
    for (int o = 1; o < 64; o <<= 1) v += __shfl_xor(v, o);
    return v;
}
__device__ __forceinline__ float row_rstd(const float* ss, int np, int row) {
    float s;
    if (np == 1) s = ss[row];
    else { const f32x4* p = (const f32x4*)(ss + (size_t)row * 16); f32x4 a = p[0], b = p[1], c = p[2], d = p[3];
        s = ((a.x + a.y) + (a.z + a.w)) + ((b.x + b.y) + (b.z + b.w)) + ((c.x + c.y) + (c.z + c.w)) + ((d.x + d.y) + (d.z + d.w)); }
    return rsqrtf(s * (1.0f / 1024.0f) + EPS);
}
#define RLX_AGENT __ATOMIC_RELAXED, __HIP_MEMORY_SCOPE_AGENT
#define LDS_FENCE() asm volatile("s_waitcnt lgkmcnt(0)" ::: "memory")
__device__ __forceinline__ f32x4 mfma_safe(bf16x8 a, bf16x8 b, f32x4 acc) {
    asm volatile("s_nop 1\n\tv_mfma_f32_16x16x32_bf16 %0, %1, %2, %0\n\ts_nop 7\n\ts_nop 7" : "+v"(acc) : "v"(a), "v"(b));
    return acc;
}


namespace pg8 {
constexpr int BM = 256, BK = 64, HALF = 128, HTB = HALF * BK * 2, STAGE_BYTES = 8 * HTB, NXCD = 8, WGM = 8;
__host__ __device__ __forceinline__ int lds_byte(int r, int c) { const int st = (r >> 4) * 2 + (c >> 5), rr = r & 15, cc = c & 31, ob = rr * 64 + cc * 2; return st * 1024 + (ob ^ (((ob >> 9) & 1) << 5)); }
__host__ __device__ __forceinline__ void stage_rc(int b, int& R, int& C) { const int st = b / 1024, sb = b % 1024, swz = sb ^ (((sb >> 9) & 1) << 5); R = (st >> 1) * 16 + swz / 64; C = (st & 1) * 32 + (swz % 64) / 2; }
__host__ __device__ __forceinline__ int perm32(int rho) { const int n = rho >> 4, i = rho & 15; return 8 * (i >> 2) + 4 * n + (i & 3); }
struct Unit { int pm, pn; };
struct Gemm { const bf16_t* A; const bf16_t* Bt; int M, N, K; };
struct StaticOrder {
    int nM, nN, nwg, G, c;
    __host__ __device__ void init(int M_, int N_, int G_, int c_) { nM = M_ / BM; nN = N_ / BM; nwg = nM * nN; G = G_; c = c_; }
    __host__ __device__ bool next(int i, Unit& u) const {
        const long L = (long)i * G + c; if (L >= nwg) return false;
        int wgid = (int)L; { const int q = nwg / NXCD, r = nwg % NXCD, xcd = wgid % NXCD, off = wgid / NXCD; wgid = (xcd < r ? xcd * (q + 1) : r * (q + 1) + (xcd - r) * q) + off; }
        const int nig = WGM * nN, gid = wgid / nig, fm = gid * WGM, gsz = (nM - fm) < WGM ? (nM - fm) : WGM;
        u.pm = fm + ((wgid % nig) % gsz); u.pn = (wgid % nig) / gsz; return true;
    }
};

struct XMap { int nx, xi, rank, nb; };
__device__ __forceinline__ int xm_ntiles(const XMap& x, int nM) { return (nM - x.xi + x.nx - 1) / x.nx; }
struct XcdOrder {
    int nN, nt, nu, rank, nb, xi, nx;
    __device__ void init(int M_, int N_, const XMap& x) { nN = N_ / BM; nt = xm_ntiles(x, M_ / BM); nu = nt * nN; rank = x.rank; nb = x.nb; xi = x.xi; nx = x.nx; }
    __device__ bool next(int i, Unit& u) const {
        const int L = i * nb + rank; if (L >= nu) return false;
        const int per = 4 * nN, g = L / per, l = L % per, gsz = (nt - 4 * g) < 4 ? (nt - 4 * g) : 4;
        u.pm = xi + (4 * g + l % gsz) * nx; u.pn = l / gsz; return true;
    }
};

template <class Epi, class Sched>
__device__ __forceinline__ void gemm_phase(LAS unsigned char* lds, const Gemm g, const Sched& S, const Epi& E) {
    const int tid = threadIdx.x, wid = __builtin_amdgcn_readfirstlane(tid >> 6), lane = tid & 63, wr = wid >> 2, wc = wid & 3, fr = lane & 15, fq = lane >> 4;
    const int K = g.K, nt = K / BK;
    unsigned voffA[2], voffB[2];
#pragma unroll
    for (int i = 0; i < 2; ++i) { int R, C; stage_rc(tid * 16 + i * 8192, R, C); const int Rb = Epi::PERM ? ((R & ~31) + perm32(R & 31)) : R;
        voffA[i] = (unsigned)(R * K + C) * 2u; voffB[i] = (unsigned)(Rb * K + C) * 2u; }
    const size_t kstep = (size_t)(BK * 2);
    const size_t hstep = (size_t)HALF * K * 2;
    const size_t tstep = 2 * hstep;
    const unsigned ldsw = (unsigned)wid * 1024u;
    const int aoff = lds_byte(wr * 64 + fr, fq * 8), boff = lds_byte(wc * 32 + fr, fq * 8);
#define PG8_SA(b, h) (((b) * 2 + (h)) * HTB)
#define PG8_SB(b, h) ((4 + (b) * 2 + (h)) * HTB)
#define PG8_STAGE(bufoff, gbase, voff) do { _Pragma("unroll") for (int _i = 0; _i < 2; ++_i) \
        __builtin_amdgcn_global_load_lds((const unsigned*)((const char*)(gbase) + (voff)[_i]), (LAS unsigned*)(lds + (bufoff) + ldsw + _i * 8192), 16, 0, 0); } while (0)
#define PG8_LDA(dst, b, h) do { _Pragma("unroll") for (int m = 0; m < 4; ++m) _Pragma("unroll") for (int k = 0; k < 2; ++k) dst[m][k] = *(const LAS bf16x8*)(lds + PG8_SA(b, h) + aoff + m * 2048 + k * 1024); } while (0)
#define PG8_LDB(dst, b, h) do { _Pragma("unroll") for (int n = 0; n < 2; ++n) _Pragma("unroll") for (int k = 0; k < 2; ++k) dst[n][k] = *(const LAS bf16x8*)(lds + PG8_SB(b, h) + boff + n * 2048 + k * 1024); } while (0)
#define PG8_MMA(ai, bj, At, Bt) do { __builtin_amdgcn_s_setprio(1); _Pragma("unroll") for (int m = 0; m < 4; ++m) _Pragma("unroll") for (int n = 0; n < 2; ++n) _Pragma("unroll") for (int k = 0; k < 2; ++k) \
        acc[ai][bj][m][n] = __builtin_amdgcn_mfma_f32_16x16x32_bf16(Bt[n][k], At[m][k], acc[ai][bj][m][n], 0, 0, 0); __builtin_amdgcn_s_setprio(0); } while (0)
#define PG8_WAIT_V(n) asm volatile("s_waitcnt vmcnt(" #n ")" ::: "memory")
#define PG8_WAIT_L(n) asm volatile("s_waitcnt lgkmcnt(" #n ")" ::: "memory")
#define PG8_BAR __builtin_amdgcn_s_barrier()
#define PG8_SCHED __builtin_amdgcn_sched_barrier(0)
    Unit cur, nxt; int ui = 0;
    if (!S.next(0, cur)) return;
    f32x4 acc[2][2][4][2];
#pragma unroll
    for (int a = 0; a < 2; ++a)
#pragma unroll
        for (int b = 0; b < 2; ++b)
#pragma unroll
            for (int m = 0; m < 4; ++m)
#pragma unroll
                for (int n = 0; n < 2; ++n) acc[a][b][m][n] = (f32x4){0.f, 0.f, 0.f, 0.f};
    bf16x8 At[4][2], B0[2][2], B1[2][2];
    const char* cA = (const char*)g.A + (size_t)cur.pm * tstep; const char* cB = (const char*)g.Bt + (size_t)cur.pn * tstep;
    PG8_STAGE(PG8_SB(0, 0), cB, voffB); PG8_STAGE(PG8_SA(0, 0), cA, voffA); PG8_STAGE(PG8_SB(0, 1), cB + hstep, voffB); PG8_STAGE(PG8_SA(0, 1), cA + hstep, voffA);
    if (wr == 1) PG8_BAR;
    PG8_WAIT_V(4); PG8_BAR;
    PG8_STAGE(PG8_SB(1, 0), cB + kstep, voffB); PG8_STAGE(PG8_SA(1, 0), cA + kstep, voffA); PG8_STAGE(PG8_SB(1, 1), cB + hstep + kstep, voffB);
    PG8_WAIT_V(6); PG8_BAR;
    for (;;) {
        const bool has_next = S.next(ui + 1, nxt);
        const char* nA = has_next ? (const char*)g.A + (size_t)nxt.pm * tstep : cA; const char* nB = has_next ? (const char*)g.Bt + (size_t)nxt.pn * tstep : cB;
        for (int t = 0; t < nt; t += 2) {
            const bool last = (t == nt - 2);
            const char* a1 = cA + (size_t)(t + 1) * kstep;
            const char* a2 = last ? nA : cA + (size_t)(t + 2) * kstep; const char* b2 = last ? nB : cB + (size_t)(t + 2) * kstep;
            const char* a3 = a2 + kstep; const char* b3 = b2 + kstep;
            PG8_LDB(B0, 0, 0); PG8_SCHED; PG8_LDA(At, 0, 0); PG8_STAGE(PG8_SA(1, 1), a1 + hstep, voffA);
            PG8_WAIT_L(8); PG8_BAR; PG8_WAIT_L(0); PG8_MMA(0, 0, At, B0); PG8_BAR; PG8_SCHED;
            PG8_LDB(B1, 0, 1); PG8_STAGE(PG8_SB(0, 0), b2, voffB);
            PG8_BAR; PG8_WAIT_L(0); PG8_MMA(0, 1, At, B1); PG8_BAR;
            PG8_LDA(At, 0, 1); PG8_STAGE(PG8_SA(0, 0), a2, voffA);
            PG8_BAR; PG8_WAIT_L(0); PG8_MMA(1, 0, At, B0); PG8_BAR; PG8_SCHED;
            PG8_STAGE(PG8_SB(0, 1), b2 + hstep, voffB);
            PG8_WAIT_V(6); PG8_BAR; PG8_MMA(1, 1, At, B1); PG8_BAR;
            PG8_LDB(B0, 1, 0); PG8_SCHED; PG8_LDA(At, 1, 0); PG8_STAGE(PG8_SA(0, 1), a2 + hstep, voffA);
            PG8_WAIT_L(8); PG8_BAR; PG8_WAIT_L(0); PG8_MMA(0, 0, At, B0); PG8_BAR; PG8_SCHED;
            PG8_LDB(B1, 1, 1); PG8_STAGE(PG8_SB(1, 0), b3, voffB);
            PG8_BAR; PG8_WAIT_L(0); PG8_MMA(0, 1, At, B1); PG8_BAR;
            PG8_LDA(At, 1, 1); PG8_STAGE(PG8_SA(1, 0), a3, voffA);
            PG8_BAR; PG8_WAIT_L(0); PG8_MMA(1, 0, At, B0); PG8_BAR; PG8_SCHED;
            PG8_STAGE(PG8_SB(1, 1), b3 + hstep, voffB);
            PG8_WAIT_V(6); PG8_BAR; PG8_MMA(1, 1, At, B1); PG8_BAR;
        }
        E(acc, cur, wr, wc, fr, fq);
        if (!has_next) break;
#pragma unroll
        for (int a = 0; a < 2; ++a)
#pragma unroll
            for (int b = 0; b < 2; ++b)
#pragma unroll
                for (int m = 0; m < 4; ++m)
#pragma unroll
                    for (int n = 0; n < 2; ++n) acc[a][b][m][n] = (f32x4){0.f, 0.f, 0.f, 0.f};
        cur = nxt; cA = nA; cB = nB; ++ui;
    }
    PG8_WAIT_V(0);
    if (wr == 0) PG8_BAR;
    PG8_BAR;
#undef PG8_SA
#undef PG8_SB
#undef PG8_STAGE
#undef PG8_LDA
#undef PG8_LDB
#undef PG8_MMA
#undef PG8_WAIT_V
#undef PG8_WAIT_L
#undef PG8_BAR
#undef PG8_SCHED
}
}
using pg8::Unit;

typedef f32x4 AccT[2][2][4][2];

template <bool GLU> struct EpiGated {
    static constexpr bool PERM = true;
    bf16_t* O; int ldc; const float* ss; int np;
    __device__ __forceinline__ void operator()(const AccT& acc, const Unit& u, int wr, int wc, int fr, int fq) const {
        const int row0 = u.pm * 256 + wr * 64 + fr, col0 = u.pn * 128 + wc * 32 + 8 * fq;
#pragma unroll
        for (int ai = 0; ai < 2; ++ai)
#pragma unroll
            for (int m = 0; m < 4; ++m) {
                const int row = row0 + ai * 128 + m * 16;
                float o[8];
                if (GLU) {
#pragma unroll
                    for (int n = 0; n < 2; ++n)
#pragma unroll
                        for (int j = 0; j < 4; ++j) o[n * 4 + j] = acc[ai][0][m][n][j] * fsigmoid(acc[ai][1][m][n][j]);
                } else {
                    const float rs = row_rstd(ss, np, row);
#pragma unroll
                    for (int n = 0; n < 2; ++n)
#pragma unroll
                        for (int j = 0; j < 4; ++j) o[n * 4 + j] = fsilu(acc[ai][0][m][n][j] * rs) * (acc[ai][1][m][n][j] * rs);
                }
                u32x4 w; w.x = cvt_pk_bf16(o[0], o[1]); w.y = cvt_pk_bf16(o[2], o[3]); w.z = cvt_pk_bf16(o[4], o[5]); w.w = cvt_pk_bf16(o[6], o[7]);
                *(u32x4*)(O + (size_t)row * ldc + col0) = w;
            }
    }
};

struct EpiRes {
    static constexpr bool PERM = false;
    const float* res0; const float* res1; float* out; bf16_t* outb; float* ssout; float scale;
    __device__ __forceinline__ void operator()(const AccT& acc, const Unit& u, int wr, int wc, int fr, int fq) const {
        const int row0 = u.pm * 256 + wr * 64 + fr, col0 = u.pn * 256 + wc * 32 + 4 * fq;
#pragma unroll
        for (int ai = 0; ai < 2; ++ai)
#pragma unroll
            for (int m = 0; m < 4; ++m) {
                const int row = row0 + ai * 128 + m * 16;
                const float* rp = (row < MP ? res0 + (size_t)row * 1024 : res1 + (size_t)(row - MP) * 1024) + col0;
                float* op = out + (size_t)row * 1024 + col0;
                float ssq = 0.f;
#pragma unroll
                for (int bj = 0; bj < 2; ++bj)
#pragma unroll
                    for (int n = 0; n < 2; ++n) {
                        const f32x4 r4 = *(const f32x4*)(rp + bj * 128 + n * 16);
                        const f32x4 v = r4 + acc[ai][bj][m][n] * scale;
                        *(f32x4*)(op + bj * 128 + n * 16) = v;
                        ssq += (v.x * v.x + v.y * v.y) + (v.z * v.z + v.w * v.w);
                        if (outb) { u32x2 w; w.x = cvt_pk_bf16(v.x, v.y); w.y = cvt_pk_bf16(v.z, v.w); *(u32x2*)(outb + (size_t)row * 1024 + col0 + bj * 128 + n * 16) = w; }
                    }
                ssq += __shfl_xor(ssq, 16); ssq += __shfl_xor(ssq, 32);
                if (fq == 0) ssout[(size_t)row * 16 + u.pn * 4 + wc] = ssq;
            }
    }
};

struct EpiZ {
    static constexpr bool PERM = true;
    bf16_t* Z; float* LA; const float* ss; const float* bgate;
    __device__ __forceinline__ void operator()(const AccT& acc, const Unit& u, int wr, int wc, int fr, int fq) const {
        const int row0 = u.pm * 256 + wr * 64 + fr, cw = wc * 32 + 8 * fq;
        const int pn = u.pn;
        const int zc0 = (pn < 6 ? pn : pn - 1) * 256;
        const int mode = (pn == 6) ? 3 : ((pn == 4 || pn == 5) ? 1 : (pn >= 9 ? 2 : 0));
#pragma unroll
        for (int ai = 0; ai < 2; ++ai)
#pragma unroll
            for (int m = 0; m < 4; ++m) {
                const int row = row0 + ai * 128 + m * 16;
                const float rs = row_rstd(ss, 16, row);
#pragma unroll
                for (int bj = 0; bj < 2; ++bj) {
                    float o[8];
#pragma unroll
                    for (int n = 0; n < 2; ++n)
#pragma unroll
                        for (int j = 0; j < 4; ++j) o[n * 4 + j] = acc[ai][bj][m][n][j] * rs;
                    const int c = bj * 128 + cw;
                    if (mode == 3) {
                        const f32x4 b0 = *(const f32x4*)(bgate + c), b1 = *(const f32x4*)(bgate + c + 4);
                        const float bb[8] = {b0.x, b0.y, b0.z, b0.w, b1.x, b1.y, b1.z, b1.w};
#pragma unroll
                        for (int i = 0; i < 8; ++i) { const float x = o[i] + bb[i]; o[i] = (fminf(x, 0.f) - __logf(1.0f + __expf(-fabsf(x)))) * (1.0f / 16.0f); }
                        float* lp = LA + (size_t)row * 256 + c;
                        *(f32x4*)lp = (f32x4){o[0], o[1], o[2], o[3]}; *(f32x4*)(lp + 4) = (f32x4){o[4], o[5], o[6], o[7]};
                    } else {
                        if (mode == 1) {
#pragma unroll
                            for (int i = 0; i < 8; ++i) o[i] = fsilu(o[i]);
                        } else if (mode == 2) {
#pragma unroll
                            for (int i = 0; i < 8; ++i) o[i] = fsigmoid(o[i]);
                        }
                        u32x4 w; w.x = cvt_pk_bf16(o[0], o[1]); w.y = cvt_pk_bf16(o[2], o[3]); w.z = cvt_pk_bf16(o[4], o[5]); w.w = cvt_pk_bf16(o[6], o[7]);
                        *(u32x4*)(Z + (size_t)row * LDZ + zc0 + c) = w;
                    }
                }
            }
    }
};

template <bool ADD> struct EpiMix {
    static constexpr bool PERM = true;
    bf16_t* T; const bf16_t* Z; int zoff;
    __device__ __forceinline__ void operator()(const AccT& acc, const Unit& u, int wr, int wc, int fr, int fq) const {
        const int row0 = u.pm * 256 + wr * 64 + fr, col0 = u.pn * 256 + wc * 32 + 8 * fq;
#pragma unroll
        for (int ai = 0; ai < 2; ++ai)
#pragma unroll
            for (int m = 0; m < 4; ++m) {
                const int row = row0 + ai * 128 + m * 16;
#pragma unroll
                for (int bj = 0; bj < 2; ++bj) {
                    const int col = col0 + bj * 128;
                    const u32x4 gw = *(const u32x4*)(Z + (size_t)row * LDZ + zoff + col);
                    float o[8];
                    o[0] = bflo(gw.x) * acc[ai][bj][m][0][0]; o[1] = bfhi(gw.x) * acc[ai][bj][m][0][1];
                    o[2] = bflo(gw.y) * acc[ai][bj][m][0][2]; o[3] = bfhi(gw.y) * acc[ai][bj][m][0][3];
                    o[4] = bflo(gw.z) * acc[ai][bj][m][1][0]; o[5] = bfhi(gw.z) * acc[ai][bj][m][1][1];
                    o[6] = bflo(gw.w) * acc[ai][bj][m][1][2]; o[7] = bfhi(gw.w) * acc[ai][bj][m][1][3];
                    bf16_t* tp = T + (size_t)row * 1024 + col;
                    if (ADD) { const u32x4 tw = *(const u32x4*)tp;
                        o[0] += bflo(tw.x); o[1] += bfhi(tw.x); o[2] += bflo(tw.y); o[3] += bfhi(tw.y);
                        o[4] += bflo(tw.z); o[5] += bfhi(tw.z); o[6] += bflo(tw.w); o[7] += bfhi(tw.w); }
                    u32x4 w; w.x = cvt_pk_bf16(o[0], o[1]); w.y = cvt_pk_bf16(o[2], o[3]); w.z = cvt_pk_bf16(o[4], o[5]); w.w = cvt_pk_bf16(o[6], o[7]);
                    *(u32x4*)tp = w;
                }
            }
    }
};

__device__ __forceinline__ void tr_item(const float* W, int ldw, int scol, int k0, const float* gain, bf16_t* WT, int ldt, int n_dst0, LAS float* scr, int lane) {
#pragma unroll 8
    for (int i = 0; i < 32; ++i) { const int kk = 2 * i + (lane >> 5); float v = W[(size_t)(k0 + kk) * ldw + scol + (lane & 31)]; if (gain) v *= gain[k0 + kk]; scr[kk * 33 + (lane & 31)] = v; }
    LDS_FENCE();
    const int c = lane & 7;
#pragma unroll
    for (int j = 0; j < 4; ++j) { const int n = (lane >> 3) + 8 * j; const LAS float* s = scr + (8 * c) * 33 + n;
        u32x4 o; o.x = cvt_pk_bf16(s[0 * 33], s[1 * 33]); o.y = cvt_pk_bf16(s[2 * 33], s[3 * 33]); o.z = cvt_pk_bf16(s[4 * 33], s[5 * 33]); o.w = cvt_pk_bf16(s[6 * 33], s[7 * 33]);
        *(u32x4*)(WT + (size_t)(n_dst0 + n) * ldt + k0 + 8 * c) = o; }
    LDS_FENCE();
}

__device__ __forceinline__ void p0_phase(const Params& P, LAS unsigned char* lds, const pg8::XMap& xm) {
    const int tid = threadIdx.x, lane = tid & 63, wave = tid >> 6;
    const int gw = blockIdx.x * 8 + wave, NGW = gridDim.x * 8;
    unsigned char* ws = P.ws;
    LAS float* scr = (LAS float*)lds + wave * (64 * 33);
    constexpr int I_GU = 16 * 176, I_D = 44 * 32, I_IN = 16 * 136, I_512 = 8 * 32, I_OUT = 16 * 32;
    constexpr int NIT = 2 * I_GU + 2 * I_D + I_IN + 3 * I_512 + I_OUT;
    if (wave < 7) for (int it = blockIdx.x * 7 + wave; it < NIT; it += gridDim.x * 7) {
        int r = it;
        if (r < 2 * I_GU) {
            const int l = r >= I_GU; r -= l * I_GU;
            const int kb = r / 176, nb = r % 176, n0 = nb * 32, pn = n0 >> 8, bj = (n0 >> 7) & 1, c = n0 & 127;
            const float* src = l ? (bj ? P.in[28] : P.in[27]) : (bj ? P.in[6] : P.in[5]);
            tr_item(src, FF, pn * 128 + c, kb * 64, l ? P.in[26] : P.in[4], (bf16_t*)(ws + (l ? WS_WGU2 : WS_WGU1)), 1024, n0, scr, lane);
            continue;
        }
        r -= 2 * I_GU;
        if (r < 2 * I_D) {
            const int l = r >= I_D; r -= l * I_D;
            const int kb = r / 32, nb = r % 32;
            tr_item(l ? P.in[29] : P.in[7], 1024, nb * 32, kb * 64, nullptr, (bf16_t*)(ws + (l ? WS_WD2 : WS_WD1)), FF, nb * 32, scr, lane);
            continue;
        }
        r -= 2 * I_D;
        if (r < I_IN) {
            const int kb = r / 136, nb = r % 136, n0 = nb * 32, k0 = kb * 64;
            bf16_t* WT = (bf16_t*)(ws + WS_WIN);
            if (n0 >= 1536 && n0 < 1792) {
                const int k = k0 + lane; const float gk = P.in[8][k];
                float a[16];
#pragma unroll
                for (int i = 0; i < 16; ++i) a[i] = gk * P.in[9][(size_t)k * 4112 + 1536 + i];
                const int j0 = n0 - 1536;
                for (int j = 0; j < 32; ++j) { float s = 0.f;
#pragma unroll
                    for (int i = 0; i < 16; ++i) s += a[i] * P.in[10][i * 256 + j0 + j];
                    WT[(size_t)(n0 + j) * 1024 + k] = f2bf(s); }
            } else {
                tr_item(P.in[9], 4112, n0 < 1536 ? n0 : n0 - 240, k0, P.in[8], WT, 1024, n0, scr, lane);
            }
            continue;
        }
        r -= I_IN;
        if (r < I_512) {
            const int kb = r / 32, nb = r % 32, n0 = nb * 32, pn = n0 >> 8, bj = (n0 >> 7) & 1, c = n0 & 127;
            tr_item(bj ? P.in[23] : P.in[22], 512, pn * 128 + c, kb * 64, nullptr, (bf16_t*)(ws + WS_WGLU), 512, n0, scr, lane);
            continue;
        }
        r -= I_512;
        if (r < 2 * I_512) {
            const int l = r >= I_512; r -= l * I_512;
            const int kb = r / 32, nb = r % 32;
            tr_item(l ? P.in[24] : P.in[13], 1024, nb * 32, kb * 64, nullptr, (bf16_t*)(ws + (l ? WS_WS5O : WS_WGO)), 512, nb * 32, scr, lane);
            continue;
        }
        r -= 2 * I_512;
        { const int kb = r / 32, nb = r % 32;
          tr_item(P.in[25], 1024, nb * 32, kb * 64, nullptr, (bf16_t*)(ws + WS_WOUT), 1024, nb * 32, scr, lane); }
    }
    bf16_t* XB = (bf16_t*)(ws + WS_RB); float* SSX = (float*)(ws + WS_SSX);
    for (int u = xm.rank * 8 + wave; u < pg8::xm_ntiles(xm, M / 256) * 256; u += xm.nb * 8) {
        const int row = (xm.xi + (u >> 8) * xm.nx) * 256 + (u & 255);
        const float* xr = row < MP ? P.in[0] + (size_t)row * 1024 : P.in[1] + (size_t)(row - MP) * 1024;
        f32x4 v[4]; float s = 0.f;
#pragma unroll
        for (int j = 0; j < 4; ++j) { v[j] = ((const f32x4*)xr)[lane + 64 * j]; s += (v[j].x * v[j].x + v[j].y * v[j].y) + (v[j].z * v[j].z + v[j].w * v[j].w); }
        s = wave_sum(s);
        if (lane == 0) SSX[row] = s;
#pragma unroll
        for (int j = 0; j < 4; ++j) { u32x2 w; w.x = cvt_pk_bf16(v[j].x, v[j].y); w.y = cvt_pk_bf16(v[j].z, v[j].w); ((u32x2*)(XB + (size_t)row * 1024))[lane + 64 * j] = w; }
    }
    const int gp = xm.rank * 512 + tid;
    unsigned char* tb = ws + WS_TBL + (size_t)xm.xi * TBL_STRIDE;
    for (int gp0 = gp; gp0 < 2048; gp0 += xm.nb * 512) { const int gp = gp0;
        const int g = gp >> 6, p = gp & 63;
        const float lr = P.in[14][gp], li = P.in[15][gp], dt = expf(P.in[16][g]);
        const float mag = expf(lr * dt); float ar = mag * cosf(li * dt), ai = mag * sinf(li * dt);
        const float nr = ar - 1.0f, ni = ai, den = lr * lr + li * li;
        const float fre = (nr * lr + ni * li) / den, fim = (ni * lr - nr * li) / den;
        bf16_t* BB = (bf16_t*)(tb + T_BB); bf16_t* CC = (bf16_t*)(tb + T_CC);
        for (int h = 0; h < 16; ++h) { const float br = P.in[17][gp * 16 + h], bi = P.in[18][gp * 16 + h];
            BB[(g * 128 + p) * 32 + h] = f2bf(fre * br - fim * bi); BB[(g * 128 + 64 + p) * 32 + h] = f2bf(fre * bi + fim * br);
            BB[(g * 128 + p) * 32 + 16 + h] = 0; BB[(g * 128 + 64 + p) * 32 + 16 + h] = 0; }
        for (int j = 0; j < 16; ++j) { CC[(g * 16 + j) * 128 + p] = f2bf(P.in[19][(g * 16 + j) * 64 + p]); CC[(g * 16 + j) * 128 + 64 + p] = f2bf(-P.in[20][(g * 16 + j) * 64 + p]); }
        float* AB = (float*)(tb + T_ABAR); AB[gp * 2] = ar; AB[gp * 2 + 1] = ai;
#pragma unroll
        for (int i = 0; i < 6; ++i) { const float t = ar * ar - ai * ai; ai = 2.0f * ar * ai; ar = t; }
        float* AB64 = (float*)(tb + T_ABAR64); AB64[gp * 2] = ar; AB64[gp * 2 + 1] = ai;
    }
}

__device__ __forceinline__ void gla_cumsum(const float (&la)[8], int w, int lane, LAS float* tot, float (&b)[8], float& blast) {
    float run = 0.f;
#pragma unroll
    for (int i = 0; i < 8; ++i) { run += la[i]; b[i] = run; }
    tot[w * 64 + lane] = run;
    __syncthreads();
    float off = 0.f, all = 0.f;
#pragma unroll
    for (int ww = 0; ww < 8; ++ww) { const float tv = tot[ww * 64 + lane]; all += tv; if (ww < w) off += tv; }
#pragma unroll
    for (int i = 0; i < 8; ++i) b[i] += off;
    blast = all;
}

constexpr int LP = 72;
constexpr int L_QS = 0, L_KS = L_QS + 64 * LP * 2, L_VT = L_KS + 64 * LP * 2, L_ST = L_VT + 128 * LP * 2, L_PS = L_ST + 128 * LP * 2, L_TOT = L_PS  , L_SSQ = L_KS  , L_GLA_END = L_PS + 64 * LP * 2;
static_assert(L_GLA_END <= 65536, "GLA LDS must stay below 64 KiB");

__device__ __forceinline__ void gla_local(const Params& P, LAS unsigned char* lds, int c, int h) {
    const int tid = threadIdx.x, lane = tid & 63, w = tid >> 6, r = lane & 15, q = lane >> 4;
    unsigned char* ws = P.ws;
    const bf16_t* Z = (const bf16_t*)(ws + WS_Z); const float* LA = (const float*)(ws + WS_LA);
    LAS bf16_t* Kt = (LAS bf16_t*)(lds + L_KS); LAS bf16_t* Vt = (LAS bf16_t*)(lds + L_VT); LAS float* tot = (LAS float*)(lds + L_TOT);
    const int row0 = c * 64;
    float b[8], blast, la[8]; unsigned kraw[8], vraw[2][8];
#pragma unroll
    for (int i = 0; i < 8; ++i) { const size_t zr = (size_t)(row0 + 8 * w + i) * LDZ;
        la[i] = LA[(size_t)(row0 + 8 * w + i) * 256 + h * 64 + lane]; kraw[i] = Z[zr + ZK + h * 64 + lane];
        vraw[0][i] = Z[zr + ZV + h * 128 + lane]; vraw[1][i] = Z[zr + ZV + h * 128 + 64 + lane]; }
    gla_cumsum(la, w, lane, tot, b, blast);
    { float kh[8];
#pragma unroll
      for (int i = 0; i < 8; ++i) kh[i] = bf2f((bf16_t)kraw[i]) * __expf(blast - b[i]);
      u32x4 o; o.x = cvt_pk_bf16(kh[0], kh[1]); o.y = cvt_pk_bf16(kh[2], kh[3]); o.z = cvt_pk_bf16(kh[4], kh[5]); o.w = cvt_pk_bf16(kh[6], kh[7]);
      *(LAS u32x4*)(Kt + lane * LP + 8 * w) = o; }
#pragma unroll
    for (int half = 0; half < 2; ++half) { const unsigned (&vv)[8] = vraw[half];
        u32x4 o; o.x = vv[0] | (vv[1] << 16); o.y = vv[2] | (vv[3] << 16); o.z = vv[4] | (vv[5] << 16); o.w = vv[6] | (vv[7] << 16);
        *(LAS u32x4*)(Vt + (half * 64 + lane) * LP + 8 * w) = o; }
    if (w == 7) ((float*)(ws + WS_DEC))[(c * 4 + h) * 64 + lane] = __expf(blast);
    __syncthreads();
    bf16_t* DS = (bf16_t*)(ws + WS_R2) + (size_t)(c * 4 + h) * 8192;
    const int dkt = w & 3;
    bf16x8 a0 = *(const LAS bf16x8*)(Kt + (dkt * 16 + r) * LP + 8 * q), a1 = *(const LAS bf16x8*)(Kt + (dkt * 16 + r) * LP + 32 + 8 * q);
#pragma unroll
    for (int n = 0; n < 4; ++n) { const int dvt = (w >> 2) * 4 + n;
        f32x4 acc = {0.f, 0.f, 0.f, 0.f};
        acc = mfma_safe(a0, *(const LAS bf16x8*)(Vt + (dvt * 16 + r) * LP + 8 * q), acc);
        acc = mfma_safe(a1, *(const LAS bf16x8*)(Vt + (dvt * 16 + r) * LP + 32 + 8 * q), acc);
#pragma unroll
        for (int j = 0; j < 4; ++j) DS[(dkt * 16 + 4 * q + j) * 128 + dvt * 16 + r] = f2bf(acc[j]); }
    __syncthreads();
}

__device__ __forceinline__ void gla_out(const Params& P, LAS unsigned char* lds, int c, int h) {
    const int tid = threadIdx.x, lane = tid & 63, w = tid >> 6, r = lane & 15, q = lane >> 4;
    unsigned char* ws = P.ws;
    const bf16_t* Z = (const bf16_t*)(ws + WS_Z); const float* LA = (const float*)(ws + WS_LA);
    LAS bf16_t* Qs = (LAS bf16_t*)(lds + L_QS); LAS bf16_t* Ks = (LAS bf16_t*)(lds + L_KS); LAS bf16_t* Vt = (LAS bf16_t*)(lds + L_VT);
    LAS bf16_t* St = (LAS bf16_t*)(lds + L_ST); LAS bf16_t* Ps = (LAS bf16_t*)(lds + L_PS); LAS float* tot = (LAS float*)(lds + L_TOT); LAS float* ssq = (LAS float*)(lds + L_SSQ);
    const int row0 = c * 64;
    float b[8], blast, la[8]; unsigned qraw[8], kraw[8], vraw[2][8], sraw[2][8];
#pragma unroll
    for (int i = 0; i < 8; ++i) { const size_t zr = (size_t)(row0 + 8 * w + i) * LDZ;
        la[i] = LA[(size_t)(row0 + 8 * w + i) * 256 + h * 64 + lane]; qraw[i] = Z[zr + ZQ + h * 64 + lane]; kraw[i] = Z[zr + ZK + h * 64 + lane];
        vraw[0][i] = Z[zr + ZV + h * 128 + lane]; vraw[1][i] = Z[zr + ZV + h * 128 + 64 + lane]; }
    if (c < 512) { const bf16_t* Sp = (const bf16_t*)(ws + WS_SPB) + (size_t)(c * 4 + h) * 8192;
#pragma unroll
        for (int i = 0; i < 8; ++i) { sraw[0][i] = Sp[(8 * w + i) * 128 + lane]; sraw[1][i] = Sp[(8 * w + i) * 128 + 64 + lane]; } }
    gla_cumsum(la, w, lane, tot, b, blast);
#pragma unroll
    for (int i = 0; i < 8; ++i) { const int t = 8 * w + i;
        const float e = __expf(b[i]);
        Qs[t * LP + lane] = f2bf(bf2f((bf16_t)qraw[i]) * e * 0.125f);
        Ks[t * LP + lane] = f2bf(bf2f((bf16_t)kraw[i]) * __builtin_amdgcn_rcpf(e)); }
#pragma unroll
    for (int half = 0; half < 2; ++half) { const unsigned (&vv)[8] = vraw[half];
        u32x4 o; o.x = vv[0] | (vv[1] << 16); o.y = vv[2] | (vv[3] << 16); o.z = vv[4] | (vv[5] << 16); o.w = vv[6] | (vv[7] << 16);
        *(LAS u32x4*)(Vt + (half * 64 + lane) * LP + 8 * w) = o; }
    if (c < 512) {
#pragma unroll
      for (int half = 0; half < 2; ++half) { const unsigned (&vv)[8] = sraw[half];
        u32x4 o; o.x = vv[0] | (vv[1] << 16); o.y = vv[2] | (vv[3] << 16); o.z = vv[4] | (vv[5] << 16); o.w = vv[6] | (vv[7] << 16);
        *(LAS u32x4*)(St + (half * 64 + lane) * LP + 8 * w) = o; }
    } else { const float* Sp = P.in[2] + (size_t)((c - 512) * 4 + h) * 8192;
#pragma unroll
      for (int half = 0; half < 2; ++half) { float sv[8];
#pragma unroll
        for (int i = 0; i < 8; ++i) sv[i] = Sp[(8 * w + i) * 128 + half * 64 + lane];
        u32x4 o; o.x = cvt_pk_bf16(sv[0], sv[1]); o.y = cvt_pk_bf16(sv[2], sv[3]); o.z = cvt_pk_bf16(sv[4], sv[5]); o.w = cvt_pk_bf16(sv[6], sv[7]);
        *(LAS u32x4*)(St + (half * 64 + lane) * LP + 8 * w) = o; } }
    __syncthreads();
#pragma unroll
    for (int i = 0; i < 2; ++i) { const int tile = w * 2 + i, tt = tile >> 2, st = tile & 3;
        f32x4 acc = {0.f, 0.f, 0.f, 0.f};
        if (st <= tt) {
#pragma unroll
            for (int k0 = 0; k0 < 64; k0 += 32)
                acc = mfma_safe(*(const LAS bf16x8*)(Qs + (tt * 16 + r) * LP + k0 + 8 * q), *(const LAS bf16x8*)(Ks + (st * 16 + r) * LP + k0 + 8 * q), acc);
        }
#pragma unroll
        for (int j = 0; j < 4; ++j) { const int t = tt * 16 + 4 * q + j, s = st * 16 + r; Ps[t * LP + s] = f2bf(s <= t ? acc[j] : 0.f); } }
    __syncthreads();
    const int tt = w >> 1, dh = w & 1;
    f32x4 oa[4];
#pragma unroll
    for (int n = 0; n < 4; ++n) oa[n] = (f32x4){0.f, 0.f, 0.f, 0.f};
#pragma unroll
    for (int k0 = 0; k0 < 64; k0 += 32) {
        const bf16x8 pa = *(const LAS bf16x8*)(Ps + (tt * 16 + r) * LP + k0 + 8 * q), qa = *(const LAS bf16x8*)(Qs + (tt * 16 + r) * LP + k0 + 8 * q);
#pragma unroll
        for (int n = 0; n < 4; ++n) { const int dv0 = (dh * 4 + n) * 16;
            oa[n] = mfma_safe(pa, *(const LAS bf16x8*)(Vt + (dv0 + r) * LP + k0 + 8 * q), oa[n]);
            oa[n] = mfma_safe(qa, *(const LAS bf16x8*)(St + (dv0 + r) * LP + k0 + 8 * q), oa[n]); }
    }
    float sq[4];
#pragma unroll
    for (int j = 0; j < 4; ++j) { float s = 0.f;
#pragma unroll
        for (int n = 0; n < 4; ++n) s += oa[n][j] * oa[n][j];
        s += __shfl_xor(s, 1); s += __shfl_xor(s, 2); s += __shfl_xor(s, 4); s += __shfl_xor(s, 8);
        sq[j] = s; }
    if (r == 0) {
#pragma unroll
        for (int j = 0; j < 4; ++j) ssq[(tt * 16 + 4 * q + j) * 2 + dh] = sq[j]; }
    __syncthreads();
    bf16_t* OG = (bf16_t*)(ws + WS_RB);
#pragma unroll
    for (int j = 0; j < 4; ++j) { const int t = tt * 16 + 4 * q + j; const size_t row = (size_t)(row0 + t);
        const float rs = rsqrtf((ssq[t * 2] + ssq[t * 2 + 1]) * (1.0f / 128.0f) + EPS);
#pragma unroll
        for (int n = 0; n < 4; ++n) { const int col = h * 128 + (dh * 4 + n) * 16 + r;
            OG[row * 512 + col] = f2bf(oa[n][j] * rs * P.in[12][col] * bf2f(Z[row * LDZ + ZR + col])); } }
    __syncthreads();
}

constexpr int S5_WAVE_LDS = 16384, S5_X_OFF = 8192, XP = 136;
template <bool FULL>
__device__ __forceinline__ void s5_wave(const Params& P, const unsigned char* tb, LAS unsigned char* wl, const pg8::XMap& xm, int NTX, int wave, int lane) {
    unsigned char* ws = P.ws;
    const int r = lane & 15, q = lane >> 4;
    const bf16_t* Z = (const bf16_t*)(ws + WS_Z);
    const bf16_t* BB = (const bf16_t*)(tb + T_BB); const bf16_t* CC = (const bf16_t*)(tb + T_CC);
    LAS float* BU = (LAS float*)wl; LAS bf16_t* X = (LAS bf16_t*)(wl + S5_X_OFF);
    bf16_t* G5 = (bf16_t*)(ws + WS_RB) + (size_t)M * 512;
    const int ustep = xm.nb * S5_NW, uend = NTX * 128;
    int gcur = -1; float ar = 0.f, ai = 0.f, dsk = 0.f;
    bf16x8 bb[8], cc[4], an[4]; unsigned uvn[4][4]; float x0r = 0.f, x0i = 0.f;
#define S5_C(uu) ((xm.xi + ((uu) >> 7) * xm.nx) * 4 + (((uu) >> 5) & 3))
#define S5_FETCH(uu) do { const int c_ = S5_C(uu), g_ = (uu) & 31, row0_ = c_ * 64; \
        _Pragma("unroll") for (int sb = 0; sb < 4; ++sb) { an[sb] = *(const bf16x8*)(Z + (size_t)(row0_ + sb * 16 + r) * LDZ + ZU + g_ * 16 + 8 * (q & 1)); \
            if (FULL) { _Pragma("unroll") for (int j = 0; j < 4; ++j) uvn[sb][j] = Z[(size_t)(row0_ + sb * 16 + 4 * q + j) * LDZ + ZU + g_ * 16 + r]; } } \
        if (FULL) { const float* x0 = (c_ < 512) ? (const float*)(ws + WS_XP) + ((size_t)(c_ * 32 + g_) * 64 + lane) * 2 : P.in[3] + ((size_t)((c_ - 512) * 32 + g_) * 64 + lane) * 2; \
            x0r = x0[0]; x0i = x0[1]; } } while (0)
    int u = xm.rank * S5_NW + wave;
    if (u < uend) S5_FETCH(u);
    for (; u < uend; u += ustep) {
        const int c = S5_C(u), g = u & 31, row0 = c * 64;
        bf16x8 a[4]; unsigned uv[4][4]; float xr = FULL ? x0r : 0.f, xi = FULL ? x0i : 0.f;
#pragma unroll
        for (int sb = 0; sb < 4; ++sb) { a[sb] = an[sb];
#pragma unroll
            for (int j = 0; j < 4; ++j) uv[sb][j] = FULL ? uvn[sb][j] : 0u; }
        if (u + ustep < uend) S5_FETCH(u + ustep);
        if (!FULL && c >= 512) continue;
        if (g != gcur) { gcur = g;
            ar = ((const float*)(tb + T_ABAR))[(g * 64 + lane) * 2]; ai = ((const float*)(tb + T_ABAR))[(g * 64 + lane) * 2 + 1];
#pragma unroll
            for (int n = 0; n < 8; ++n) bb[n] = *(const bf16x8*)(BB + (g * 128 + n * 16 + r) * 32 + 8 * q);
            if (FULL) { dsk = P.in[21][g * 16 + r];
#pragma unroll
                for (int kk = 0; kk < 4; ++kk) cc[kk] = *(const bf16x8*)(CC + (g * 16 + r) * 128 + kk * 32 + 8 * q); } }
#pragma unroll
        for (int sb = 0; sb < 4; ++sb) {
#pragma unroll
            for (int n = 0; n < 8; ++n) {
                f32x4 acc = {0.f, 0.f, 0.f, 0.f};
                acc = mfma_safe(a[sb], bb[n], acc);
#pragma unroll
                for (int j = 0; j < 4; ++j) BU[(4 * q + j) * 128 + n * 16 + r] = acc[j];
            }
            LDS_FENCE();
#pragma unroll 4
            for (int t = 0; t < 16; ++t) {
                const float br = BU[t * 128 + lane], bi = BU[t * 128 + 64 + lane];
                const float nxr = ar * xr - ai * xi + br, nxi = ar * xi + ai * xr + bi;
                xr = nxr; xi = nxi;
                if (FULL) { X[t * XP + lane] = f2bf(xr); X[t * XP + 64 + lane] = f2bf(xi); }
            }
            LDS_FENCE();
            if (FULL) {
                f32x4 y = {0.f, 0.f, 0.f, 0.f};
#pragma unroll
                for (int kk = 0; kk < 4; ++kk) y = mfma_safe(*(const LAS bf16x8*)(X + r * XP + kk * 32 + 8 * q), cc[kk], y);
#pragma unroll
                for (int j = 0; j < 4; ++j) { const size_t row = (size_t)(row0 + sb * 16 + 4 * q + j);
                    const float yv = y[j] + dsk * bf2f((bf16_t)uv[sb][j]);
                    const float gl = yv * fsigmoid(1.5957691216f * (yv + 0.044715f * yv * yv * yv));
                    G5[row * 512 + g * 16 + r] = f2bf(gl); }
                LDS_FENCE();
            }
        }
        if (!FULL) { float* E = (float*)(ws + WS_E) + ((size_t)(c * 32 + g) * 64 + lane) * 2; E[0] = xr; E[1] = xi; }
        else if (c >= 512) { float* o = P.out + O_S5S + ((size_t)((c - 512) * 32 + g) * 64 + lane) * 2; o[0] = xr; o[1] = xi; }
    }
#undef S5_C
#undef S5_FETCH
}

__device__ __forceinline__ void carry_phase(const Params& P, const unsigned char* tb) {
    unsigned char* ws = P.ws;
    const int gid = blockIdx.x * 512 + threadIdx.x, NT = gridDim.x * 512;
    const bf16_t* DS = (const bf16_t*)(ws + WS_R2); bf16_t* SPB = (bf16_t*)(ws + WS_SPB); const float* DEC = (const float*)(ws + WS_DEC);
    for (int e = gid; e < 65536; e += NT) {
        const int bh = e >> 13, el = e & 8191, dk = el >> 7, bb = bh >> 2, h = bh & 3;
        float S = 0.f;
        for (int c = 0; c < 256; c += 16) {
            unsigned vr[16]; float d[16];
#pragma unroll
            for (int i = 0; i < 16; ++i) { const int ch = bb * 256 + c + i; vr[i] = DS[(size_t)(ch * 4 + h) * 8192 + el]; d[i] = DEC[(ch * 4 + h) * 64 + dk]; }
#pragma unroll
            for (int i = 0; i < 16; ++i) { const int ch = bb * 256 + c + i; SPB[(size_t)(ch * 4 + h) * 8192 + el] = f2bf(S); S = d[i] * S + bf2f((bf16_t)vr[i]); }
        }
        P.out[O_GLAP + e] = S;
    }
    for (int e = gid; e < 524288; e += NT) {
        const int sh = e >> 13, el = e & 8191, dk = el >> 7, ch = 512 * 4 + sh;
        P.out[O_GLAS + e] = DEC[ch * 64 + dk] * P.in[2][e] + bf2f(DS[(size_t)ch * 8192 + el]);
    }
    for (int e = gid; e < 4096; e += NT) {
        const int bb = e >> 11, gp = e & 2047;
        const float ar = ((const float*)(tb + T_ABAR64))[gp * 2], ai = ((const float*)(tb + T_ABAR64))[gp * 2 + 1];
        const f32x2* E = (const f32x2*)(ws + WS_E); f32x2* XPv = (f32x2*)(ws + WS_XP);
        float xr = 0.f, xi = 0.f;
        for (int c = 0; c < 256; c += 8) {
            f32x2 v[8];
#pragma unroll
            for (int i = 0; i < 8; ++i) v[i] = E[(size_t)(bb * 256 + c + i) * 2048 + gp];
#pragma unroll
            for (int i = 0; i < 8; ++i) { XPv[(size_t)(bb * 256 + c + i) * 2048 + gp] = (f32x2){xr, xi};
                const float nxr = ar * xr - ai * xi + v[i].x, nxi = ar * xi + ai * xr + v[i].y; xr = nxr; xi = nxi; }
        }
        P.out[O_S5P + (size_t)e * 2] = xr; P.out[O_S5P + (size_t)e * 2 + 1] = xi;
    }
}

__global__ void __launch_bounds__(512, 2) fwd_kernel(Params P) {
    extern __shared__ __attribute__((aligned(16))) unsigned char smem[];
    LAS unsigned char* lds = (LAS unsigned char*)smem;
    cg::grid_group grid = cg::this_grid();
    unsigned char* ws = P.ws;
    const int lo = P.ph_lo, hi = P.ph_hi;
    const int G = gridDim.x, bx = blockIdx.x;
    const int tid = threadIdx.x, lane = tid & 63, wave = tid >> 6;
#define IN(k) (lo <= (k) && (k) < hi)
#define SEAM(k) do { if (IN(k) && IN((k) + 1)) { asm volatile("s_waitcnt vmcnt(0)" ::: "memory"); __syncthreads(); grid.sync(); \
        __builtin_amdgcn_fence(__ATOMIC_ACQUIRE, "agent"); asm volatile("s_waitcnt vmcnt(0)" ::: "memory"); __syncthreads(); } } while (0)
    float* Y = P.out + O_Y;
    bf16_t* RB = (bf16_t*)(ws + WS_RB); bf16_t* ZB = (bf16_t*)(ws + WS_Z); bf16_t* ACT = ZB; bf16_t* GLU = (bf16_t*)(ws + WS_LA); bf16_t* TM = (bf16_t*)(ws + WS_R2);
    float* LA = (float*)(ws + WS_LA);
    float* SSX = (float*)(ws + WS_SSX); float* SSH = (float*)(ws + WS_SSH); float* SS2 = (float*)(ws + WS_SS2); float* SS3 = (float*)(ws + WS_SS3);

    pg8::XMap xm;
    {
        unsigned* ctl = (unsigned*)(ws + WS_CTL) + 64 * (hi - lo == N_PHASES ? 0 : 1 + lo);
        LAS unsigned* lw = (LAS unsigned*)(lds + LDS_BYTES - 16);
        const unsigned xcc = (unsigned)__builtin_amdgcn_s_getreg((3 << 11) | 20) & 0xFu;
        if (tid == 0) { lw[0] = __hip_atomic_fetch_add(ctl + xcc, 1u, RLX_AGENT); lw[1] = xcc; }
        asm volatile("s_waitcnt vmcnt(0)" ::: "memory"); __syncthreads(); grid.sync(); __syncthreads();
        int nx = 0, xi = 0;
        for (int j = 0; j < 16; ++j) { const unsigned cj = __hip_atomic_load(ctl + j, RLX_AGENT); if (cj) { if (j < (int)lw[1]) ++xi; ++nx; } }
        xm.nx = nx; xm.xi = xi; xm.rank = (int)lw[0]; xm.nb = (int)__hip_atomic_load(ctl + lw[1], RLX_AGENT);
        __syncthreads();
    }
    const int NTX = pg8::xm_ntiles(xm, M / 256);
    if (IN(0)) p0_phase(P, lds, xm);
    SEAM(0);
    if (IN(1)) { pg8::Gemm g{RB, (const bf16_t*)(ws + WS_WGU1), M, 5632, 1024}; pg8::XcdOrder S; S.init(M, 5632, xm);
        EpiGated<false> E{ACT, FF, SSX, 1}; pg8::gemm_phase(lds, g, S, E); }
    SEAM(1);
    if (IN(2)) { pg8::Gemm g{ACT, (const bf16_t*)(ws + WS_WD1), M, 1024, FF}; pg8::XcdOrder S; S.init(M, 1024, xm);
        EpiRes E{P.in[0], P.in[1], Y, RB, SSH, 0.5f}; pg8::gemm_phase(lds, g, S, E); }
    SEAM(2);
    if (IN(3)) { pg8::Gemm g{RB, (const bf16_t*)(ws + WS_WIN), M, NZ, 1024}; pg8::XcdOrder S; S.init(M, NZ, xm);
        EpiZ E{ZB, LA, SSH, P.in[11]}; pg8::gemm_phase(lds, g, S, E); }
    SEAM(3);
    for (int rep = 0; rep < TIMING_REP_MIXER; ++rep) {
    if (IN(4)) {
        for (int u = xm.rank; u < NTX * 16; u += xm.nb) gla_local(P, lds, (xm.xi + (u >> 4) * xm.nx) * 4 + ((u >> 2) & 3), u & 3);
        if (wave < S5_NW) s5_wave<false>(P, ws + WS_TBL + (size_t)xm.xi * TBL_STRIDE, lds + wave * S5_WAVE_LDS, xm, NTX, wave, lane);
    }
    SEAM(4);
    if (IN(5)) carry_phase(P, ws + WS_TBL + (size_t)xm.xi * TBL_STRIDE);
    SEAM(5);
    if (IN(6)) {
        for (int u = xm.rank; u < NTX * 16; u += xm.nb) gla_out(P, lds, (xm.xi + (u >> 4) * xm.nx) * 4 + ((u >> 2) & 3), u & 3);
        if (wave < S5_NW) s5_wave<true>(P, ws + WS_TBL + (size_t)xm.xi * TBL_STRIDE, lds + wave * S5_WAVE_LDS, xm, NTX, wave, lane);
        __syncthreads();
    }
    SEAM(6);
    }
    if (IN(7)) {
        { pg8::Gemm g{RB + (size_t)M * 512, (const bf16_t*)(ws + WS_WGLU), M, 1024, 512}; pg8::XcdOrder S; S.init(M, 1024, xm);
          EpiGated<true> E{GLU, 512, nullptr, 0}; pg8::gemm_phase(lds, g, S, E); }
        { pg8::Gemm g{RB, (const bf16_t*)(ws + WS_WGO), M, 1024, 512}; pg8::XcdOrder S; S.init(M, 1024, xm);
          EpiMix<false> E{TM, ZB, ZGG}; pg8::gemm_phase(lds, g, S, E); }
    }
    SEAM(7);
    if (IN(8)) { pg8::Gemm g{GLU, (const bf16_t*)(ws + WS_WS5O), M, 1024, 512}; pg8::XcdOrder S; S.init(M, 1024, xm);
        EpiMix<true> E{TM, ZB, ZG5}; pg8::gemm_phase(lds, g, S, E); }
    SEAM(8);
    if (IN(9)) { pg8::Gemm g{TM, (const bf16_t*)(ws + WS_WOUT), M, 1024, 1024}; pg8::XcdOrder S; S.init(M, 1024, xm);
        EpiRes E{Y, Y + (size_t)MP * 1024, Y, RB, SS2, 1.0f}; pg8::gemm_phase(lds, g, S, E); }
    SEAM(9);
    if (IN(10)) { pg8::Gemm g{RB, (const bf16_t*)(ws + WS_WGU2), M, 5632, 1024}; pg8::XcdOrder S; S.init(M, 5632, xm);
        EpiGated<false> E{ACT, FF, SS2, 16}; pg8::gemm_phase(lds, g, S, E); }
    SEAM(10);
    if (IN(11)) { pg8::Gemm g{ACT, (const bf16_t*)(ws + WS_WD2), M, 1024, FF}; pg8::XcdOrder S; S.init(M, 1024, xm);
        EpiRes E{Y, Y + (size_t)MP * 1024, Y, nullptr, SS3, 0.5f}; pg8::gemm_phase(lds, g, S, E); }
    SEAM(11);
    if (IN(12)) {
        const float* gf = P.in[30];
        for (int u = xm.rank * 8 + wave; u < NTX * 256; u += xm.nb * 8) {
            const int row = (xm.xi + (u >> 8) * xm.nx) * 256 + (u & 255);
            const float rs = row_rstd(SS3, 16, row);
            f32x4* yr = (f32x4*)(Y + (size_t)row * 1024);
#pragma unroll
            for (int j = 0; j < 4; ++j) { const f32x4 v = yr[lane + 64 * j], gg = ((const f32x4*)gf)[lane + 64 * j]; yr[lane + 64 * j] = v * rs * gg; }
        }
        asm volatile("s_waitcnt vmcnt(0)" ::: "memory"); __threadfence_system(); asm volatile("s_waitcnt vmcnt(0)" ::: "memory");
    }
}

extern "C" void kernel_launch(void* const* d_in, const int* in_sizes, int n_in, void* d_out, int out_size, void* d_ws, size_t ws_size, hipStream_t stream) {
    static int grid_blocks = 0;
    if (grid_blocks == 0) {
        if (n_in != 31 || ws_size < WS_END) { fprintf(stderr, "kernel_launch: need 31 inputs and >= %zu bytes of workspace; got %d, %zu\n", (size_t)WS_END, n_in, ws_size); grid_blocks = -1; return; }
        int dev = 0, cus = 0, per_cu = 0;
        hipGetDevice(&dev);
        hipDeviceGetAttribute(&cus, hipDeviceAttributeMultiprocessorCount, dev);
        if (hipFuncSetAttribute((const void*)fwd_kernel, hipFuncAttributeMaxDynamicSharedMemorySize, LDS_BYTES) != hipSuccess) { fprintf(stderr, "kernel_launch: hipFuncSetAttribute failed\n"); grid_blocks = -1; return; }
        if (hipOccupancyMaxActiveBlocksPerMultiprocessor(&per_cu, (const void*)fwd_kernel, 512, LDS_BYTES) != hipSuccess || per_cu < 1) { fprintf(stderr, "kernel_launch: occupancy query gave %d\n", per_cu); per_cu = 1; }
        (void)hipGetLastError();
        grid_blocks = cus * 1;
        fprintf(stderr, "kernel_launch: cus %d per_cu %d grid %d\n", cus, per_cu, grid_blocks);
    }
    if (grid_blocks < 0) return;
    hipMemsetAsync((unsigned char*)d_ws + WS_CTL, 0, 8192, stream);
    Params p{};
    for (int i = 0; i < 31; ++i) p.in[i] = (const float*)d_in[i];
    p.out = (float*)d_out; p.ws = (unsigned char*)d_ws;
    p.ph_lo = 0; p.ph_hi = N_PHASES;
    void* args[] = {&p};
    hipError_t e = hipLaunchCooperativeKernel((const void*)fwd_kernel, dim3(grid_blocks), dim3(512), args, LDS_BYTES, stream);
    if (e != hipSuccess) fprintf(stderr, "cooperative launch failed: %s (grid %d)\n", hipGetErrorString(e), grid_blocks);
}
```

```cpp
#include <hip/hip_runtime.h>
#include <hip/hip_cooperative_groups.h>
#include <cstdio>
#include <cstdint>
namespace cg = cooperative_groups;


#define LAS __attribute__((address_space(3)))
typedef unsigned short bf16_t;
typedef short bf16x8 __attribute__((ext_vector_type(8)));
typedef float f32x4 __attribute__((ext_vector_type(4)));
typedef float f32x2 __attribute__((ext_vector_type(2)));
typedef unsigned u32x4 __attribute__((ext_vector_type(4)));
typedef unsigned u32x2 __attribute__((ext_vector_type(2)));

constexpr int MP = 32768;
constexpr int MS = 1024;
constexpr int M = MP + MS;
constexpr int D = 1024, FF = 2816;
constexpr int NZ = 4352;
constexpr int LDZ = 4096;
constexpr int ZQ = 0, ZK = 256, ZV = 512, ZR = 1024, ZU = 1536, ZGG = 2048, ZG5 = 3072;
constexpr int NCH = 528;
constexpr float EPS = 1e-6f;

constexpr size_t SZ_WGU = (size_t)5632 * 1024 * 2, SZ_WD = (size_t)1024 * 2816 * 2, SZ_WIN = (size_t)NZ * 1024 * 2;
constexpr size_t SZ_W512 = (size_t)1024 * 512 * 2, SZ_WOUT = (size_t)1024 * 1024 * 2;
constexpr size_t WS_WGU1 = 0;
constexpr size_t WS_WD1 = WS_WGU1 + SZ_WGU;
constexpr size_t WS_WIN = WS_WD1 + SZ_WD;
constexpr size_t WS_WGLU = WS_WIN + SZ_WIN;
constexpr size_t WS_WGO = WS_WGLU + SZ_W512;
constexpr size_t WS_WS5O = WS_WGO + SZ_W512;
constexpr size_t WS_WOUT = WS_WS5O + SZ_W512;
constexpr size_t WS_WGU2 = WS_WOUT + SZ_WOUT;
constexpr size_t WS_WD2 = WS_WGU2 + SZ_WGU;
constexpr size_t WS_RB = WS_WD2 + SZ_WD;
constexpr size_t SZ_RB = (size_t)M * 1024 * 2;
constexpr size_t WS_Z = WS_RB + SZ_RB;
constexpr size_t SZ_Z = (size_t)M * LDZ * 2;
constexpr size_t WS_LA = WS_Z + SZ_Z;
constexpr size_t SZ_LA = (size_t)M * 256 * 4;
constexpr size_t WS_R2 = WS_LA + SZ_LA;
constexpr size_t WS_SPB = WS_R2 + (size_t)NCH * 4 * 8192 * 2;
constexpr size_t SZ_R2 = (size_t)M * 1024 * 2;
constexpr size_t WS_SSX = WS_R2 + SZ_R2;
constexpr size_t WS_SSH = WS_SSX + (size_t)M * 4;
constexpr size_t WS_SS2 = WS_SSH + (size_t)M * 64;
constexpr size_t WS_SS3 = WS_SS2 + (size_t)M * 64;
constexpr size_t WS_DEC = WS_SS3 + (size_t)M * 64;
constexpr size_t WS_E = WS_DEC + (size_t)NCH * 4 * 64 * 4;
constexpr size_t WS_TBL = WS_E + (size_t)512 * 32 * 64 * 2 * 4;
constexpr size_t T_ABAR = 0, T_ABAR64 = 16384, T_BB = 32768, T_CC = T_BB + 262144, TBL_STRIDE = T_CC + 131072;
constexpr size_t WS_CC_END = WS_TBL + 16 * TBL_STRIDE;
constexpr size_t WS_XP = WS_CC_END;
constexpr size_t WS_CTL = WS_XP + (size_t)512 * 32 * 64 * 2 * 4;
constexpr size_t WS_END = WS_CTL + 8192;

constexpr size_t O_Y = 0, O_GLAP = (size_t)M * 1024, O_S5P = O_GLAP + 65536, O_GLAS = O_S5P + 8192, O_S5S = O_GLAS + 524288;

constexpr int LDS_BYTES = 147456;
constexpr int N_PHASES = 13;
#ifndef TIMING_REP_MIXER
#define TIMING_REP_MIXER 1
#endif
constexpr int S5_NW = 4;

struct Params {
    const float* in[31];
    float* out;
    unsigned char* ws;
    int ph_lo, ph_hi;
};

__device__ __forceinline__ unsigned cvt_pk_bf16(float lo, float hi) { unsigned r; asm volatile("v_cvt_pk_bf16_f32 %0, %1, %2" : "=v"(r) : "v"(lo), "v"(hi)); return r; }
__device__ __forceinline__ bf16_t f2bf(float f) { return (bf16_t)(cvt_pk_bf16(f, 0.f) & 0xffffu); }
__device__ __forceinline__ float bf2f(bf16_t b) { return __uint_as_float(((unsigned)b) << 16); }
__device__ __forceinline__ float bflo(unsigned w) { return __uint_as_float(w << 16); }
__device__ __forceinline__ float bfhi(unsigned w) { return __uint_as_float(w & 0xffff0000u); }
__device__ __forceinline__ float fsigmoid(float x) { return __builtin_amdgcn_rcpf(1.0f + __expf(-x)); }
__device__ __forceinline__ float fsilu(float x) { return x * fsigmoid(x); }
__device__ __forceinline__ float wave_sum(float v) {
#pragma unroll
    for (int o = 1; o < 64; o <<= 1) v += __shfl_xor(v, o);
    return v;
}
__device__ __forceinline__ float row_rstd(const float* ss, int np, int row) {
    float s;
    if (np == 1) s = ss[row];
    else { const f32x4* p = (const f32x4*)(ss + (size_t)row * 16); f32x4 a = p[0], b = p[1], c = p[2], d = p[3];
        s = ((a.x + a.y) + (a.z + a.w)) + ((b.x + b.y) + (b.z + b.w)) + ((c.x + c.y) + (c.z + c.w)) + ((d.x + d.y) + (d.z + d.w)); }
    return rsqrtf(s * (1.0f / 1024.0f) + EPS);
}
#define RLX_AGENT __ATOMIC_RELAXED, __HIP_MEMORY_SCOPE_AGENT
#define LDS_FENCE() asm volatile("s_waitcnt lgkmcnt(0)" ::: "memory")
__device__ __forceinline__ f32x4 mfma_safe(bf16x8 a, bf16x8 b, f32x4 acc) {
    asm volatile("s_nop 1\n\tv_mfma_f32_16x16x32_bf16 %0, %1, %2, %0\n\ts_nop 7\n\ts_nop 7" : "+v"(acc) : "v"(a), "v"(b));
    return acc;
}


namespace pg8 {
constexpr int BM = 256, BK = 64, HALF = 128, HTB = HALF * BK * 2, STAGE_BYTES = 8 * HTB, NXCD = 8, WGM = 8;
__host__ __device__ __forceinline__ int lds_byte(int r, int c) { const int st = (r >> 4) * 2 + (c >> 5), rr = r & 15, cc = c & 31, ob = rr * 64 + cc * 2; return st * 1024 + (ob ^ (((ob >> 9) & 1) << 5)); }
__host__ __device__ __forceinline__ void stage_rc(int b, int& R, int& C) { const int st = b / 1024, sb = b % 1024, swz = sb ^ (((sb >> 9) & 1) << 5); R = (st >> 1) * 16 + swz / 64; C = (st & 1) * 32 + (swz % 64) / 2; }
__host__ __device__ __forceinline__ int perm32(int rho) { const int n = rho >> 4, i = rho & 15; return 8 * (i >> 2) + 4 * n + (i & 3); }
struct Unit { int pm, pn; };
struct Gemm { const bf16_t* A; const bf16_t* Bt; int M, N, K; };
struct StaticOrder {
    int nM, nN, nwg, G, c;
    __host__ __device__ void init(int M_, int N_, int G_, int c_) { nM = M_ / BM; nN = N_ / BM; nwg = nM * nN; G = G_; c = c_; }
    __host__ __device__ bool next(int i, Unit& u) const {
        const long L = (long)i * G + c; if (L >= nwg) return false;
        int wgid = (int)L; { const int q = nwg / NXCD, r = nwg % NXCD, xcd = wgid % NXCD, off = wgid / NXCD; wgid = (xcd < r ? xcd * (q + 1) : r * (q + 1) + (xcd - r) * q) + off; }
        const int nig = WGM * nN, gid = wgid / nig, fm = gid * WGM, gsz = (nM - fm) < WGM ? (nM - fm) : WGM;
        u.pm = fm + ((wgid % nig) % gsz); u.pn = (wgid % nig) / gsz; return true;
    }
};

struct XMap { int nx, xi, rank, nb; };
__device__ __forceinline__ int xm_ntiles(const XMap& x, int nM) { return (nM - x.xi + x.nx - 1) / x.nx; }
struct XcdOrder {
    static constexpr int TG = 8;
    int nN, nt, nu, rank, nb, xi, nx;
    __device__ void init(int M_, int N_, const XMap& x) { nN = N_ / BM; nt = xm_ntiles(x, M_ / BM); nu = nt * nN; rank = x.rank; nb = x.nb; xi = x.xi; nx = x.nx; }
    __device__ bool next(int i, Unit& u) const {
        const int L = i * nb + rank; if (L >= nu) return false;
        const int per = TG * nN, g = L / per, l = L % per, gsz = (nt - TG * g) < TG ? (nt - TG * g) : TG;
        u.pm = xi + (TG * g + l % gsz) * nx; u.pn = l / gsz; return true;
    }
};

template <class Epi, class Sched>
__device__ __forceinline__ void gemm_phase(LAS unsigned char* lds, const Gemm g, const Sched& S, const Epi& E) {
    const int tid = threadIdx.x, wid = __builtin_amdgcn_readfirstlane(tid >> 6), lane = tid & 63, wr = wid >> 2, wc = wid & 3, fr = lane & 15, fq = lane >> 4;
    const int K = g.K, nt = K / BK;
    unsigned voffA[2], voffB[2];
#pragma unroll
    for (int i = 0; i < 2; ++i) { int R, C; stage_rc(tid * 16 + i * 8192, R, C); const int Rb = Epi::PERM ? ((R & ~31) + perm32(R & 31)) : R;
        voffA[i] = (unsigned)(R * K + C) * 2u; voffB[i] = (unsigned)(Rb * K + C) * 2u; }
    const size_t kstep = (size_t)(BK * 2);
    const size_t hstep = (size_t)HALF * K * 2;
    const size_t tstep = 2 * hstep;
    const unsigned ldsw = (unsigned)wid * 1024u;
    const int aoff = lds_byte(wr * 64 + fr, fq * 8), boff = lds_byte(wc * 32 + fr, fq * 8);
#define PG8_SA(b, h) (((b) * 2 + (h)) * HTB)
#define PG8_SB(b, h) ((4 + (b) * 2 + (h)) * HTB)
#define PG8_STAGE(bufoff, gbase, voff) do { _Pragma("unroll") for (int _i = 0; _i < 2; ++_i) \
        __builtin_amdgcn_global_load_lds((const unsigned*)((const char*)(gbase) + (voff)[_i]), (LAS unsigned*)(lds + (bufoff) + ldsw + _i * 8192), 16, 0, 0); } while (0)
#define PG8_LDA(dst, b, h) do { _Pragma("unroll") for (int m = 0; m < 4; ++m) _Pragma("unroll") for (int k = 0; k < 2; ++k) dst[m][k] = *(const LAS bf16x8*)(lds + PG8_SA(b, h) + aoff + m * 2048 + k * 1024); } while (0)
#define PG8_LDB(dst, b, h) do { _Pragma("unroll") for (int n = 0; n < 2; ++n) _Pragma("unroll") for (int k = 0; k < 2; ++k) dst[n][k] = *(const LAS bf16x8*)(lds + PG8_SB(b, h) + boff + n * 2048 + k * 1024); } while (0)
#define PG8_MMA(ai, bj, At, Bt) do { __builtin_amdgcn_s_setprio(1); _Pragma("unroll") for (int m = 0; m < 4; ++m) _Pragma("unroll") for (int n = 0; n < 2; ++n) _Pragma("unroll") for (int k = 0; k < 2; ++k) \
        acc[ai][bj][m][n] = __builtin_amdgcn_mfma_f32_16x16x32_bf16(Bt[n][k], At[m][k], acc[ai][bj][m][n], 0, 0, 0); __builtin_amdgcn_s_setprio(0); } while (0)
#define PG8_WAIT_V(n) asm volatile("s_waitcnt vmcnt(" #n ")" ::: "memory")
#define PG8_WAIT_L(n) asm volatile("s_waitcnt lgkmcnt(" #n ")" ::: "memory")
#define PG8_BAR __builtin_amdgcn_s_barrier()
#define PG8_SCHED __builtin_amdgcn_sched_barrier(0)
    Unit cur, nxt; int ui = 0;
    if (!S.next(0, cur)) return;
    f32x4 acc[2][2][4][2];
#pragma unroll
    for (int a = 0; a < 2; ++a)
#pragma unroll
        for (int b = 0; b < 2; ++b)
#pragma unroll
            for (int m = 0; m < 4; ++m)
#pragma unroll
                for (int n = 0; n < 2; ++n) acc[a][b][m][n] = (f32x4){0.f, 0.f, 0.f, 0.f};
    bf16x8 At[4][2], B0[2][2], B1[2][2];
    const char* cA = (const char*)g.A + (size_t)cur.pm * tstep; const char* cB = (const char*)g.Bt + (size_t)cur.pn * tstep;
    PG8_STAGE(PG8_SB(0, 0), cB, voffB); PG8_STAGE(PG8_SA(0, 0), cA, voffA); PG8_STAGE(PG8_SB(0, 1), cB + hstep, voffB); PG8_STAGE(PG8_SA(0, 1), cA + hstep, voffA);
    if (wr == 1) PG8_BAR;
    PG8_WAIT_V(4); PG8_BAR;
    PG8_STAGE(PG8_SB(1, 0), cB + kstep, voffB); PG8_STAGE(PG8_SA(1, 0), cA + kstep, voffA); PG8_STAGE(PG8_SB(1, 1), cB + hstep + kstep, voffB);
    PG8_WAIT_V(6); PG8_BAR;
    for (;;) {
        const bool has_next = S.next(ui + 1, nxt);
        const char* nA = has_next ? (const char*)g.A + (size_t)nxt.pm * tstep : cA; const char* nB = has_next ? (const char*)g.Bt + (size_t)nxt.pn * tstep : cB;
        for (int t = 0; t < nt; t += 2) {
            const bool last = (t == nt - 2);
            const char* a1 = cA + (size_t)(t + 1) * kstep;
            const char* a2 = last ? nA : cA + (size_t)(t + 2) * kstep; const char* b2 = last ? nB : cB + (size_t)(t + 2) * kstep;
            const char* a3 = a2 + kstep; const char* b3 = b2 + kstep;
            PG8_LDB(B0, 0, 0); PG8_SCHED; PG8_LDA(At, 0, 0); PG8_STAGE(PG8_SA(1, 1), a1 + hstep, voffA);
            PG8_WAIT_L(8); PG8_BAR; PG8_WAIT_L(0); PG8_MMA(0, 0, At, B0); PG8_BAR; PG8_SCHED;
            PG8_LDB(B1, 0, 1); PG8_STAGE(PG8_SB(0, 0), b2, voffB);
            PG8_BAR; PG8_WAIT_L(0); PG8_MMA(0, 1, At, B1); PG8_BAR;
            PG8_LDA(At, 0, 1); PG8_STAGE(PG8_SA(0, 0), a2, voffA);
            PG8_BAR; PG8_WAIT_L(0); PG8_MMA(1, 0, At, B0); PG8_BAR; PG8_SCHED;
            PG8_STAGE(PG8_SB(0, 1), b2 + hstep, voffB);
            PG8_WAIT_V(6); PG8_BAR; PG8_MMA(1, 1, At, B1); PG8_BAR;
            PG8_LDB(B0, 1, 0); PG8_SCHED; PG8_LDA(At, 1, 0); PG8_STAGE(PG8_SA(0, 1), a2 + hstep, voffA);
            PG8_WAIT_L(8); PG8_BAR; PG8_WAIT_L(0); PG8_MMA(0, 0, At, B0); PG8_BAR; PG8_SCHED;
            PG8_LDB(B1, 1, 1); PG8_STAGE(PG8_SB(1, 0), b3, voffB);
            PG8_BAR; PG8_WAIT_L(0); PG8_MMA(0, 1, At, B1); PG8_BAR;
            PG8_LDA(At, 1, 1); PG8_STAGE(PG8_SA(1, 0), a3, voffA);
            PG8_BAR; PG8_WAIT_L(0); PG8_MMA(1, 0, At, B0); PG8_BAR; PG8_SCHED;
            PG8_STAGE(PG8_SB(1, 1), b3 + hstep, voffB);
            PG8_WAIT_V(6); PG8_BAR; PG8_MMA(1, 1, At, B1); PG8_BAR;
        }
        E(acc, cur, wr, wc, fr, fq);
        if (!has_next) break;
#pragma unroll
        for (int a = 0; a < 2; ++a)
#pragma unroll
            for (int b = 0; b < 2; ++b)
#pragma unroll
                for (int m = 0; m < 4; ++m)
#pragma unroll
                    for (int n = 0; n < 2; ++n) acc[a][b][m][n] = (f32x4){0.f, 0.f, 0.f, 0.f};
        cur = nxt; cA = nA; cB = nB; ++ui;
    }
    PG8_WAIT_V(0);
    if (wr == 0) PG8_BAR;
    PG8_BAR;
#undef PG8_SA
#undef PG8_SB
#undef PG8_STAGE
#undef PG8_LDA
#undef PG8_LDB
#undef PG8_MMA
#undef PG8_WAIT_V
#undef PG8_WAIT_L
#undef PG8_BAR
#undef PG8_SCHED
}
}
using pg8::Unit;

typedef f32x4 AccT[2][2][4][2];

template <bool GLU> struct EpiGated {
    static constexpr bool PERM = true;
    bf16_t* O; int ldc; const float* ss; int np;
    __device__ __forceinline__ void operator()(const AccT& acc, const Unit& u, int wr, int wc, int fr, int fq) const {
        const int row0 = u.pm * 256 + wr * 64 + fr, col0 = u.pn * 128 + wc * 32 + 8 * fq;
#pragma unroll
        for (int ai = 0; ai < 2; ++ai)
#pragma unroll
            for (int m = 0; m < 4; ++m) {
                const int row = row0 + ai * 128 + m * 16;
                float o[8];
                if (GLU) {
#pragma unroll
                    for (int n = 0; n < 2; ++n)
#pragma unroll
                        for (int j = 0; j < 4; ++j) o[n * 4 + j] = acc[ai][0][m][n][j] * fsigmoid(acc[ai][1][m][n][j]);
                } else {
                    const float rs = row_rstd(ss, np, row);
#pragma unroll
                    for (int n = 0; n < 2; ++n)
#pragma unroll
                        for (int j = 0; j < 4; ++j) o[n * 4 + j] = fsilu(acc[ai][0][m][n][j] * rs) * (acc[ai][1][m][n][j] * rs);
                }
                u32x4 w; w.x = cvt_pk_bf16(o[0], o[1]); w.y = cvt_pk_bf16(o[2], o[3]); w.z = cvt_pk_bf16(o[4], o[5]); w.w = cvt_pk_bf16(o[6], o[7]);
                *(u32x4*)(O + (size_t)row * ldc + col0) = w;
            }
    }
};

struct EpiRes {
    static constexpr bool PERM = false;
    const float* res0; const float* res1; float* out; bf16_t* outb; float* ssout; float scale;
    __device__ __forceinline__ void operator()(const AccT& acc, const Unit& u, int wr, int wc, int fr, int fq) const {
        const int row0 = u.pm * 256 + wr * 64 + fr, col0 = u.pn * 256 + wc * 32 + 4 * fq;
#pragma unroll
        for (int ai = 0; ai < 2; ++ai)
#pragma unroll
            for (int m = 0; m < 4; ++m) {
                const int row = row0 + ai * 128 + m * 16;
                const float* rp = (row < MP ? res0 + (size_t)row * 1024 : res1 + (size_t)(row - MP) * 1024) + col0;
                float* op = out + (size_t)row * 1024 + col0;
                float ssq = 0.f;
#pragma unroll
                for (int bj = 0; bj < 2; ++bj)
#pragma unroll
                    for (int n = 0; n < 2; ++n) {
                        const f32x4 r4 = *(const f32x4*)(rp + bj * 128 + n * 16);
                        const f32x4 v = r4 + acc[ai][bj][m][n] * scale;
                        *(f32x4*)(op + bj * 128 + n * 16) = v;
                        ssq += (v.x * v.x + v.y * v.y) + (v.z * v.z + v.w * v.w);
                        if (outb) { u32x2 w; w.x = cvt_pk_bf16(v.x, v.y); w.y = cvt_pk_bf16(v.z, v.w); *(u32x2*)(outb + (size_t)row * 1024 + col0 + bj * 128 + n * 16) = w; }
                    }
                ssq += __shfl_xor(ssq, 16); ssq += __shfl_xor(ssq, 32);
                if (fq == 0) ssout[(size_t)row * 16 + u.pn * 4 + wc] = ssq;
            }
    }
};

struct EpiZ {
    static constexpr bool PERM = true;
    bf16_t* Z; float* LA; const float* ss; const float* bgate;
    __device__ __forceinline__ void operator()(const AccT& acc, const Unit& u, int wr, int wc, int fr, int fq) const {
        const int row0 = u.pm * 256 + wr * 64 + fr, cw = wc * 32 + 8 * fq;
        const int pn = u.pn;
        const int zc0 = (pn < 6 ? pn : pn - 1) * 256;
        const int mode = (pn == 6) ? 3 : ((pn == 4 || pn == 5) ? 1 : (pn >= 9 ? 2 : 0));
#pragma unroll
        for (int ai = 0; ai < 2; ++ai)
#pragma unroll
            for (int m = 0; m < 4; ++m) {
                const int row = row0 + ai * 128 + m * 16;
                const float rs = row_rstd(ss, 16, row);
#pragma unroll
                for (int bj = 0; bj < 2; ++bj) {
                    float o[8];
#pragma unroll
                    for (int n = 0; n < 2; ++n)
#pragma unroll
                        for (int j = 0; j < 4; ++j) o[n * 4 + j] = acc[ai][bj][m][n][j] * rs;
                    const int c = bj * 128 + cw;
                    if (mode == 3) {
                        const f32x4 b0 = *(const f32x4*)(bgate + c), b1 = *(const f32x4*)(bgate + c + 4);
                        const float bb[8] = {b0.x, b0.y, b0.z, b0.w, b1.x, b1.y, b1.z, b1.w};
#pragma unroll
                        for (int i = 0; i < 8; ++i) { const float x = o[i] + bb[i]; o[i] = (fminf(x, 0.f) - __logf(1.0f + __expf(-fabsf(x)))) * (1.0f / 16.0f); }
                        float* lp = LA + (size_t)row * 256 + c;
                        *(f32x4*)lp = (f32x4){o[0], o[1], o[2], o[3]}; *(f32x4*)(lp + 4) = (f32x4){o[4], o[5], o[6], o[7]};
                    } else {
                        if (mode == 1) {
#pragma unroll
                            for (int i = 0; i < 8; ++i) o[i] = fsilu(o[i]);
                        } else if (mode == 2) {
#pragma unroll
                            for (int i = 0; i < 8; ++i) o[i] = fsigmoid(o[i]);
                        }
                        u32x4 w; w.x = cvt_pk_bf16(o[0], o[1]); w.y = cvt_pk_bf16(o[2], o[3]); w.z = cvt_pk_bf16(o[4], o[5]); w.w = cvt_pk_bf16(o[6], o[7]);
                        *(u32x4*)(Z + (size_t)row * LDZ + zc0 + c) = w;
                    }
                }
            }
    }
};

template <bool ADD> struct EpiMix {
    static constexpr bool PERM = true;
    bf16_t* T; const bf16_t* Z; int zoff;
    __device__ __forceinline__ void operator()(const AccT& acc, const Unit& u, int wr, int wc, int fr, int fq) const {
        const int row0 = u.pm * 256 + wr * 64 + fr, col0 = u.pn * 256 + wc * 32 + 8 * fq;
#pragma unroll
        for (int ai = 0; ai < 2; ++ai)
#pragma unroll
            for (int m = 0; m < 4; ++m) {
                const int row = row0 + ai * 128 + m * 16;
#pragma unroll
                for (int bj = 0; bj < 2; ++bj) {
                    const int col = col0 + bj * 128;
                    const u32x4 gw = *(const u32x4*)(Z + (size_t)row * LDZ + zoff + col);
                    float o[8];
                    o[0] = bflo(gw.x) * acc[ai][bj][m][0][0]; o[1] = bfhi(gw.x) * acc[ai][bj][m][0][1];
                    o[2] = bflo(gw.y) * acc[ai][bj][m][0][2]; o[3] = bfhi(gw.y) * acc[ai][bj][m][0][3];
                    o[4] = bflo(gw.z) * acc[ai][bj][m][1][0]; o[5] = bfhi(gw.z) * acc[ai][bj][m][1][1];
                    o[6] = bflo(gw.w) * acc[ai][bj][m][1][2]; o[7] = bfhi(gw.w) * acc[ai][bj][m][1][3];
                    bf16_t* tp = T + (size_t)row * 1024 + col;
                    if (ADD) { const u32x4 tw = *(const u32x4*)tp;
                        o[0] += bflo(tw.x); o[1] += bfhi(tw.x); o[2] += bflo(tw.y); o[3] += bfhi(tw.y);
                        o[4] += bflo(tw.z); o[5] += bfhi(tw.z); o[6] += bflo(tw.w); o[7] += bfhi(tw.w); }
                    u32x4 w; w.x = cvt_pk_bf16(o[0], o[1]); w.y = cvt_pk_bf16(o[2], o[3]); w.z = cvt_pk_bf16(o[4], o[5]); w.w = cvt_pk_bf16(o[6], o[7]);
                    *(u32x4*)tp = w;
                }
            }
    }
};

__device__ __forceinline__ void tr_item(const float* W, int ldw, int scol, int k0, const float* gain, bf16_t* WT, int ldt, int n_dst0, LAS float* scr, int lane) {
#pragma unroll 8
    for (int i = 0; i < 32; ++i) { const int kk = 2 * i + (lane >> 5); float v = W[(size_t)(k0 + kk) * ldw + scol + (lane & 31)]; if (gain) v *= gain[k0 + kk]; scr[kk * 33 + (lane & 31)] = v; }
    LDS_FENCE();
    const int c = lane & 7;
#pragma unroll
    for (int j = 0; j < 4; ++j) { const int n = (lane >> 3) + 8 * j; const LAS float* s = scr + (8 * c) * 33 + n;
        u32x4 o; o.x = cvt_pk_bf16(s[0 * 33], s[1 * 33]); o.y = cvt_pk_bf16(s[2 * 33], s[3 * 33]); o.z = cvt_pk_bf16(s[4 * 33], s[5 * 33]); o.w = cvt_pk_bf16(s[6 * 33], s[7 * 33]);
        *(u32x4*)(WT + (size_t)(n_dst0 + n) * ldt + k0 + 8 * c) = o; }
    LDS_FENCE();
}

__device__ __forceinline__ void p0_phase(const Params& P, LAS unsigned char* lds, const pg8::XMap& xm) {
    const int tid = threadIdx.x, lane = tid & 63, wave = tid >> 6;
    const int gw = blockIdx.x * 8 + wave, NGW = gridDim.x * 8;
    unsigned char* ws = P.ws;
    LAS float* scr = (LAS float*)lds + wave * (64 * 33);
    constexpr int I_GU = 16 * 176, I_D = 44 * 32, I_IN = 16 * 136, I_512 = 8 * 32, I_OUT = 16 * 32;
    constexpr int NIT = 2 * I_GU + 2 * I_D + I_IN + 3 * I_512 + I_OUT;
    if (wave < 7) for (int it = blockIdx.x * 7 + wave; it < NIT; it += gridDim.x * 7) {
        int r = it;
        if (r < 2 * I_GU) {
            const int l = r >= I_GU; r -= l * I_GU;
            const int kb = r / 176, nb = r % 176, n0 = nb * 32, pn = n0 >> 8, bj = (n0 >> 7) & 1, c = n0 & 127;
            const float* src = l ? (bj ? P.in[28] : P.in[27]) : (bj ? P.in[6] : P.in[5]);
            tr_item(src, FF, pn * 128 + c, kb * 64, l ? P.in[26] : P.in[4], (bf16_t*)(ws + (l ? WS_WGU2 : WS_WGU1)), 1024, n0, scr, lane);
            continue;
        }
        r -= 2 * I_GU;
        if (r < 2 * I_D) {
            const int l = r >= I_D; r -= l * I_D;
            const int kb = r / 32, nb = r % 32;
            tr_item(l ? P.in[29] : P.in[7], 1024, nb * 32, kb * 64, nullptr, (bf16_t*)(ws + (l ? WS_WD2 : WS_WD1)), FF, nb * 32, scr, lane);
            continue;
        }
        r -= 2 * I_D;
        if (r < I_IN) {
            const int kb = r / 136, nb = r % 136, n0 = nb * 32, k0 = kb * 64;
            bf16_t* WT = (bf16_t*)(ws + WS_WIN);
            if (n0 >= 1536 && n0 < 1792) {
                const int k = k0 + lane; const float gk = P.in[8][k];
                float a[16];
#pragma unroll
                for (int i = 0; i < 16; ++i) a[i] = gk * P.in[9][(size_t)k * 4112 + 1536 + i];
                const int j0 = n0 - 1536;
                for (int j = 0; j < 32; ++j) { float s = 0.f;
#pragma unroll
                    for (int i = 0; i < 16; ++i) s += a[i] * P.in[10][i * 256 + j0 + j];
                    WT[(size_t)(n0 + j) * 1024 + k] = f2bf(s); }
            } else {
                tr_item(P.in[9], 4112, n0 < 1536 ? n0 : n0 - 240, k0, P.in[8], WT, 1024, n0, scr, lane);
            }
            continue;
        }
        r -= I_IN;
        if (r < I_512) {
            const int kb = r / 32, nb = r % 32, n0 = nb * 32, pn = n0 >> 8, bj = (n0 >> 7) & 1, c = n0 & 127;
            tr_item(bj ? P.in[23] : P.in[22], 512, pn * 128 + c, kb * 64, nullptr, (bf16_t*)(ws + WS_WGLU), 512, n0, scr, lane);
            continue;
        }
        r -= I_512;
        if (r < 2 * I_512) {
            const int l = r >= I_512; r -= l * I_512;
            const int kb = r / 32, nb = r % 32;
            tr_item(l ? P.in[24] : P.in[13], 1024, nb * 32, kb * 64, nullptr, (bf16_t*)(ws + (l ? WS_WS5O : WS_WGO)), 512, nb * 32, scr, lane);
            continue;
        }
        r -= 2 * I_512;
        { const int kb = r / 32, nb = r % 32;
          tr_item(P.in[25], 1024, nb * 32, kb * 64, nullptr, (bf16_t*)(ws + WS_WOUT), 1024, nb * 32, scr, lane); }
    }
    bf16_t* XB = (bf16_t*)(ws + WS_RB); float* SSX = (float*)(ws + WS_SSX);
    for (int u = xm.rank * 8 + wave; u < pg8::xm_ntiles(xm, M / 256) * 256; u += xm.nb * 8) {
        const int row = (xm.xi + (u >> 8) * xm.nx) * 256 + (u & 255);
        const float* xr = row < MP ? P.in[0] + (size_t)row * 1024 : P.in[1] + (size_t)(row - MP) * 1024;
        f32x4 v[4]; float s = 0.f;
#pragma unroll
        for (int j = 0; j < 4; ++j) { v[j] = ((const f32x4*)xr)[lane + 64 * j]; s += (v[j].x * v[j].x + v[j].y * v[j].y) + (v[j].z * v[j].z + v[j].w * v[j].w); }
        s = wave_sum(s);
        if (lane == 0) SSX[row] = s;
#pragma unroll
        for (int j = 0; j < 4; ++j) { u32x2 w; w.x = cvt_pk_bf16(v[j].x, v[j].y); w.y = cvt_pk_bf16(v[j].z, v[j].w); ((u32x2*)(XB + (size_t)row * 1024))[lane + 64 * j] = w; }
    }
    const int gp = xm.rank * 512 + tid;
    unsigned char* tb = ws + WS_TBL + (size_t)xm.xi * TBL_STRIDE;
    for (int gp0 = gp; gp0 < 2048; gp0 += xm.nb * 512) { const int gp = gp0;
        const int g = gp >> 6, p = gp & 63;
        const float lr = P.in[14][gp], li = P.in[15][gp], dt = expf(P.in[16][g]);
        const float mag = expf(lr * dt); float ar = mag * cosf(li * dt), ai = mag * sinf(li * dt);
        const float nr = ar - 1.0f, ni = ai, den = lr * lr + li * li;
        const float fre = (nr * lr + ni * li) / den, fim = (ni * lr - nr * li) / den;
        bf16_t* BB = (bf16_t*)(tb + T_BB); bf16_t* CC = (bf16_t*)(tb + T_CC);
        for (int h = 0; h < 16; ++h) { const float br = P.in[17][gp * 16 + h], bi = P.in[18][gp * 16 + h];
            BB[(g * 128 + p) * 32 + h] = f2bf(fre * br - fim * bi); BB[(g * 128 + 64 + p) * 32 + h] = f2bf(fre * bi + fim * br);
            BB[(g * 128 + p) * 32 + 16 + h] = 0; BB[(g * 128 + 64 + p) * 32 + 16 + h] = 0; }
        for (int j = 0; j < 16; ++j) { CC[(g * 16 + j) * 128 + p] = f2bf(P.in[19][(g * 16 + j) * 64 + p]); CC[(g * 16 + j) * 128 + 64 + p] = f2bf(-P.in[20][(g * 16 + j) * 64 + p]); }
        float* AB = (float*)(tb + T_ABAR); AB[gp * 2] = ar; AB[gp * 2 + 1] = ai;
#pragma unroll
        for (int i = 0; i < 6; ++i) { const float t = ar * ar - ai * ai; ai = 2.0f * ar * ai; ar = t; }
        float* AB64 = (float*)(tb + T_ABAR64); AB64[gp * 2] = ar; AB64[gp * 2 + 1] = ai;
    }
}

__device__ __forceinline__ void gla_cumsum(const float (&la)[8], int w, int lane, LAS float* tot, float (&b)[8], float& blast) {
    float run = 0.f;
#pragma unroll
    for (int i = 0; i < 8; ++i) { run += la[i]; b[i] = run; }
    tot[w * 64 + lane] = run;
    __syncthreads();
    float off = 0.f, all = 0.f;
#pragma unroll
    for (int ww = 0; ww < 8; ++ww) { const float tv = tot[ww * 64 + lane]; all += tv; if (ww < w) off += tv; }
#pragma unroll
    for (int i = 0; i < 8; ++i) b[i] += off;
    blast = all;
}

constexpr int LP = 72;
constexpr int L_QS = 0, L_KS = L_QS + 64 * LP * 2, L_VT = L_KS + 64 * LP * 2, L_ST = L_VT + 128 * LP * 2, L_PS = L_ST + 128 * LP * 2, L_TOT = L_PS  , L_SSQ = L_KS  , L_GLA_END = L_PS + 64 * LP * 2;
static_assert(L_GLA_END <= 65536, "GLA LDS must stay below 64 KiB");

__device__ __forceinline__ void gla_local(const Params& P, LAS unsigned char* lds, int c, int h) {
    const int tid = threadIdx.x, lane = tid & 63, w = tid >> 6, r = lane & 15, q = lane >> 4;
    unsigned char* ws = P.ws;
    const bf16_t* Z = (const bf16_t*)(ws + WS_Z); const float* LA = (const float*)(ws + WS_LA);
    LAS bf16_t* Kt = (LAS bf16_t*)(lds + L_KS); LAS bf16_t* Vt = (LAS bf16_t*)(lds + L_VT); LAS float* tot = (LAS float*)(lds + L_TOT);
    const int row0 = c * 64;
    float b[8], blast, la[8]; unsigned kraw[8], vraw[2][8];
#pragma unroll
    for (int i = 0; i < 8; ++i) { const size_t zr = (size_t)(row0 + 8 * w + i) * LDZ;
        la[i] = LA[(size_t)(row0 + 8 * w + i) * 256 + h * 64 + lane]; kraw[i] = Z[zr + ZK + h * 64 + lane];
        vraw[0][i] = Z[zr + ZV + h * 128 + lane]; vraw[1][i] = Z[zr + ZV + h * 128 + 64 + lane]; }
    gla_cumsum(la, w, lane, tot, b, blast);
    { float kh[8];
#pragma unroll
      for (int i = 0; i < 8; ++i) kh[i] = bf2f((bf16_t)kraw[i]) * __expf(blast - b[i]);
      u32x4 o; o.x = cvt_pk_bf16(kh[0], kh[1]); o.y = cvt_pk_bf16(kh[2], kh[3]); o.z = cvt_pk_bf16(kh[4], kh[5]); o.w = cvt_pk_bf16(kh[6], kh[7]);
      *(LAS u32x4*)(Kt + lane * LP + 8 * w) = o; }
#pragma unroll
    for (int half = 0; half < 2; ++half) { const unsigned (&vv)[8] = vraw[half];
        u32x4 o; o.x = vv[0] | (vv[1] << 16); o.y = vv[2] | (vv[3] << 16); o.z = vv[4] | (vv[5] << 16); o.w = vv[6] | (vv[7] << 16);
        *(LAS u32x4*)(Vt + (half * 64 + lane) * LP + 8 * w) = o; }
    if (w == 7) ((float*)(ws + WS_DEC))[(c * 4 + h) * 64 + lane] = __expf(blast);
    __syncthreads();
    bf16_t* DS = (bf16_t*)(ws + WS_R2) + (size_t)(c * 4 + h) * 8192;
    const int dkt = w & 3;
    bf16x8 a0 = *(const LAS bf16x8*)(Kt + (dkt * 16 + r) * LP + 8 * q), a1 = *(const LAS bf16x8*)(Kt + (dkt * 16 + r) * LP + 32 + 8 * q);
#pragma unroll
    for (int n = 0; n < 4; ++n) { const int dvt = (w >> 2) * 4 + n;
        f32x4 acc = {0.f, 0.f, 0.f, 0.f};
        acc = mfma_safe(a0, *(const LAS bf16x8*)(Vt + (dvt * 16 + r) * LP + 8 * q), acc);
        acc = mfma_safe(a1, *(const LAS bf16x8*)(Vt + (dvt * 16 + r) * LP + 32 + 8 * q), acc);
#pragma unroll
        for (int j = 0; j < 4; ++j) DS[(dkt * 16 + 4 * q + j) * 128 + dvt * 16 + r] = f2bf(acc[j]); }
    __syncthreads();
}

__device__ __forceinline__ void gla_out(const Params& P, LAS unsigned char* lds, int c, int h) {
    const int tid = threadIdx.x, lane = tid & 63, w = tid >> 6, r = lane & 15, q = lane >> 4;
    unsigned char* ws = P.ws;
    const bf16_t* Z = (const bf16_t*)(ws + WS_Z); const float* LA = (const float*)(ws + WS_LA);
    LAS bf16_t* Qs = (LAS bf16_t*)(lds + L_QS); LAS bf16_t* Ks = (LAS bf16_t*)(lds + L_KS); LAS bf16_t* Vt = (LAS bf16_t*)(lds + L_VT);
    LAS bf16_t* St = (LAS bf16_t*)(lds + L_ST); LAS bf16_t* Ps = (LAS bf16_t*)(lds + L_PS); LAS float* tot = (LAS float*)(lds + L_TOT); LAS float* ssq = (LAS float*)(lds + L_SSQ);
    const int row0 = c * 64;
    float b[8], blast, la[8]; unsigned qraw[8], kraw[8], vraw[2][8], sraw[2][8];
#pragma unroll
    for (int i = 0; i < 8; ++i) { const size_t zr = (size_t)(row0 + 8 * w + i) * LDZ;
        la[i] = LA[(size_t)(row0 + 8 * w + i) * 256 + h * 64 + lane]; qraw[i] = Z[zr + ZQ + h * 64 + lane]; kraw[i] = Z[zr + ZK + h * 64 + lane];
        vraw[0][i] = Z[zr + ZV + h * 128 + lane]; vraw[1][i] = Z[zr + ZV + h * 128 + 64 + lane]; }
    if (c < 512) { const bf16_t* Sp = (const bf16_t*)(ws + WS_SPB) + (size_t)(c * 4 + h) * 8192;
#pragma unroll
        for (int i = 0; i < 8; ++i) { sraw[0][i] = Sp[(8 * w + i) * 128 + lane]; sraw[1][i] = Sp[(8 * w + i) * 128 + 64 + lane]; } }
    gla_cumsum(la, w, lane, tot, b, blast);
#pragma unroll
    for (int i = 0; i < 8; ++i) { const int t = 8 * w + i;
        const float e = __expf(b[i]);
        Qs[t * LP + lane] = f2bf(bf2f((bf16_t)qraw[i]) * e * 0.125f);
        Ks[t * LP + lane] = f2bf(bf2f((bf16_t)kraw[i]) * __builtin_amdgcn_rcpf(e)); }
#pragma unroll
    for (int half = 0; half < 2; ++half) { const unsigned (&vv)[8] = vraw[half];
        u32x4 o; o.x = vv[0] | (vv[1] << 16); o.y = vv[2] | (vv[3] << 16); o.z = vv[4] | (vv[5] << 16); o.w = vv[6] | (vv[7] << 16);
        *(LAS u32x4*)(Vt + (half * 64 + lane) * LP + 8 * w) = o; }
    if (c < 512) {
#pragma unroll
      for (int half = 0; half < 2; ++half) { const unsigned (&vv)[8] = sraw[half];
        u32x4 o; o.x = vv[0] | (vv[1] << 16); o.y = vv[2] | (vv[3] << 16); o.z = vv[4] | (vv[5] << 16); o.w = vv[6] | (vv[7] << 16);
        *(LAS u32x4*)(St + (half * 64 + lane) * LP + 8 * w) = o; }
    } else { const float* Sp = P.in[2] + (size_t)((c - 512) * 4 + h) * 8192;
#pragma unroll
      for (int half = 0; half < 2; ++half) { float sv[8];
#pragma unroll
        for (int i = 0; i < 8; ++i) sv[i] = Sp[(8 * w + i) * 128 + half * 64 + lane];
        u32x4 o; o.x = cvt_pk_bf16(sv[0], sv[1]); o.y = cvt_pk_bf16(sv[2], sv[3]); o.z = cvt_pk_bf16(sv[4], sv[5]); o.w = cvt_pk_bf16(sv[6], sv[7]);
        *(LAS u32x4*)(St + (half * 64 + lane) * LP + 8 * w) = o; } }
    __syncthreads();
#pragma unroll
    for (int i = 0; i < 2; ++i) { const int tile = w * 2 + i, tt = tile >> 2, st = tile & 3;
        f32x4 acc = {0.f, 0.f, 0.f, 0.f};
        if (st <= tt) {
#pragma unroll
            for (int k0 = 0; k0 < 64; k0 += 32)
                acc = mfma_safe(*(const LAS bf16x8*)(Qs + (tt * 16 + r) * LP + k0 + 8 * q), *(const LAS bf16x8*)(Ks + (st * 16 + r) * LP + k0 + 8 * q), acc);
        }
#pragma unroll
        for (int j = 0; j < 4; ++j) { const int t = tt * 16 + 4 * q + j, s = st * 16 + r; Ps[t * LP + s] = f2bf(s <= t ? acc[j] : 0.f); } }
    __syncthreads();
    const int tt = w >> 1, dh = w & 1;
    f32x4 oa[4];
#pragma unroll
    for (int n = 0; n < 4; ++n) oa[n] = (f32x4){0.f, 0.f, 0.f, 0.f};
#pragma unroll
    for (int k0 = 0; k0 < 64; k0 += 32) {
        const bf16x8 pa = *(const LAS bf16x8*)(Ps + (tt * 16 + r) * LP + k0 + 8 * q), qa = *(const LAS bf16x8*)(Qs + (tt * 16 + r) * LP + k0 + 8 * q);
#pragma unroll
        for (int n = 0; n < 4; ++n) { const int dv0 = (dh * 4 + n) * 16;
            oa[n] = mfma_safe(pa, *(const LAS bf16x8*)(Vt + (dv0 + r) * LP + k0 + 8 * q), oa[n]);
            oa[n] = mfma_safe(qa, *(const LAS bf16x8*)(St + (dv0 + r) * LP + k0 + 8 * q), oa[n]); }
    }
    float sq[4];
#pragma unroll
    for (int j = 0; j < 4; ++j) { float s = 0.f;
#pragma unroll
        for (int n = 0; n < 4; ++n) s += oa[n][j] * oa[n][j];
        s += __shfl_xor(s, 1); s += __shfl_xor(s, 2); s += __shfl_xor(s, 4); s += __shfl_xor(s, 8);
        sq[j] = s; }
    if (r == 0) {
#pragma unroll
        for (int j = 0; j < 4; ++j) ssq[(tt * 16 + 4 * q + j) * 2 + dh] = sq[j]; }
    __syncthreads();
    bf16_t* OG = (bf16_t*)(ws + WS_RB);
#pragma unroll
    for (int j = 0; j < 4; ++j) { const int t = tt * 16 + 4 * q + j; const size_t row = (size_t)(row0 + t);
        const float rs = rsqrtf((ssq[t * 2] + ssq[t * 2 + 1]) * (1.0f / 128.0f) + EPS);
#pragma unroll
        for (int n = 0; n < 4; ++n) { const int col = h * 128 + (dh * 4 + n) * 16 + r;
            OG[row * 512 + col] = f2bf(oa[n][j] * rs * P.in[12][col] * bf2f(Z[row * LDZ + ZR + col])); } }
    __syncthreads();
}

constexpr int S5_WAVE_LDS = 16384, S5_X_OFF = 8192, XP = 136;
template <bool FULL>
__device__ __forceinline__ void s5_wave(const Params& P, const unsigned char* tb, LAS unsigned char* wl, const pg8::XMap& xm, int NTX, int wave, int lane) {
    unsigned char* ws = P.ws;
    const int r = lane & 15, q = lane >> 4;
    const bf16_t* Z = (const bf16_t*)(ws + WS_Z);
    const bf16_t* BB = (const bf16_t*)(tb + T_BB); const bf16_t* CC = (const bf16_t*)(tb + T_CC);
    LAS float* BU = (LAS float*)wl; LAS bf16_t* X = (LAS bf16_t*)(wl + S5_X_OFF);
    bf16_t* G5 = (bf16_t*)(ws + WS_RB) + (size_t)M * 512;
    const int ustep = xm.nb * S5_NW, uend = NTX * 128;
    int gcur = -1; float ar = 0.f, ai = 0.f, dsk = 0.f;
    bf16x8 bb[8], cc[4], an[4]; unsigned uvn[4][4]; float x0r = 0.f, x0i = 0.f;
#define S5_C(uu) ((xm.xi + ((uu) >> 7) * xm.nx) * 4 + (((uu) >> 5) & 3))
#define S5_FETCH(uu) do { const int c_ = S5_C(uu), g_ = (uu) & 31, row0_ = c_ * 64; \
        _Pragma("unroll") for (int sb = 0; sb < 4; ++sb) { an[sb] = *(const bf16x8*)(Z + (size_t)(row0_ + sb * 16 + r) * LDZ + ZU + g_ * 16 + 8 * (q & 1)); \
            if (FULL) { _Pragma("unroll") for (int j = 0; j < 4; ++j) uvn[sb][j] = Z[(size_t)(row0_ + sb * 16 + 4 * q + j) * LDZ + ZU + g_ * 16 + r]; } } \
        if (FULL) { const float* x0 = (c_ < 512) ? (const float*)(ws + WS_XP) + ((size_t)(c_ * 32 + g_) * 64 + lane) * 2 : P.in[3] + ((size_t)((c_ - 512) * 32 + g_) * 64 + lane) * 2; \
            x0r = x0[0]; x0i = x0[1]; } } while (0)
    int u = xm.rank * S5_NW + wave;
    if (u < uend) S5_FETCH(u);
    for (; u < uend; u += ustep) {
        const int c = S5_C(u), g = u & 31, row0 = c * 64;
        bf16x8 a[4]; unsigned uv[4][4]; float xr = FULL ? x0r : 0.f, xi = FULL ? x0i : 0.f;
#pragma unroll
        for (int sb = 0; sb < 4; ++sb) { a[sb] = an[sb];
#pragma unroll
            for (int j = 0; j < 4; ++j) uv[sb][j] = FULL ? uvn[sb][j] : 0u; }
        if (u + ustep < uend) S5_FETCH(u + ustep);
        if (!FULL && c >= 512) continue;
        if (g != gcur) { gcur = g;
            ar = ((const float*)(tb + T_ABAR))[(g * 64 + lane) * 2]; ai = ((const float*)(tb + T_ABAR))[(g * 64 + lane) * 2 + 1];
#pragma unroll
            for (int n = 0; n < 8; ++n) bb[n] = *(const bf16x8*)(BB + (g * 128 + n * 16 + r) * 32 + 8 * q);
            if (FULL) { dsk = P.in[21][g * 16 + r];
#pragma unroll
                for (int kk = 0; kk < 4; ++kk) cc[kk] = *(const bf16x8*)(CC + (g * 16 + r) * 128 + kk * 32 + 8 * q); } }
#pragma unroll
        for (int sb = 0; sb < 4; ++sb) {
#pragma unroll
            for (int n = 0; n < 8; ++n) {
                f32x4 acc = {0.f, 0.f, 0.f, 0.f};
                acc = mfma_safe(a[sb], bb[n], acc);
#pragma unroll
                for (int j = 0; j < 4; ++j) BU[(4 * q + j) * 128 + n * 16 + r] = acc[j];
            }
            LDS_FENCE();
#pragma unroll 4
            for (int t = 0; t < 16; ++t) {
                const float br = BU[t * 128 + lane], bi = BU[t * 128 + 64 + lane];
                const float nxr = ar * xr - ai * xi + br, nxi = ar * xi + ai * xr + bi;
                xr = nxr; xi = nxi;
                if (FULL) { X[t * XP + lane] = f2bf(xr); X[t * XP + 64 + lane] = f2bf(xi); }
            }
            LDS_FENCE();
            if (FULL) {
                f32x4 y = {0.f, 0.f, 0.f, 0.f};
#pragma unroll
                for (int kk = 0; kk < 4; ++kk) y = mfma_safe(*(const LAS bf16x8*)(X + r * XP + kk * 32 + 8 * q), cc[kk], y);
#pragma unroll
                for (int j = 0; j < 4; ++j) { const size_t row = (size_t)(row0 + sb * 16 + 4 * q + j);
                    const float yv = y[j] + dsk * bf2f((bf16_t)uv[sb][j]);
                    const float gl = yv * fsigmoid(1.5957691216f * (yv + 0.044715f * yv * yv * yv));
                    G5[row * 512 + g * 16 + r] = f2bf(gl); }
                LDS_FENCE();
            }
        }
        if (!FULL) { float* E = (float*)(ws + WS_E) + ((size_t)(c * 32 + g) * 64 + lane) * 2; E[0] = xr; E[1] = xi; }
        else if (c >= 512) { float* o = P.out + O_S5S + ((size_t)((c - 512) * 32 + g) * 64 + lane) * 2; o[0] = xr; o[1] = xi; }
    }
#undef S5_C
#undef S5_FETCH
}

__device__ __forceinline__ void carry_phase(const Params& P, const unsigned char* tb) {
    unsigned char* ws = P.ws;
    const int gid = blockIdx.x * 512 + threadIdx.x, NT = gridDim.x * 512;
    const bf16_t* DS = (const bf16_t*)(ws + WS_R2); bf16_t* SPB = (bf16_t*)(ws + WS_SPB); const float* DEC = (const float*)(ws + WS_DEC);
    for (int e = gid; e < 65536; e += NT) {
        const int bh = e >> 13, el = e & 8191, dk = el >> 7, bb = bh >> 2, h = bh & 3;
        float S = 0.f;
        for (int c = 0; c < 256; c += 16) {
            unsigned vr[16]; float d[16];
#pragma unroll
            for (int i = 0; i < 16; ++i) { const int ch = bb * 256 + c + i; vr[i] = DS[(size_t)(ch * 4 + h) * 8192 + el]; d[i] = DEC[(ch * 4 + h) * 64 + dk]; }
#pragma unroll
            for (int i = 0; i < 16; ++i) { const int ch = bb * 256 + c + i; SPB[(size_t)(ch * 4 + h) * 8192 + el] = f2bf(S); S = d[i] * S + bf2f((bf16_t)vr[i]); }
        }
        P.out[O_GLAP + e] = S;
    }
    for (int e = gid; e < 524288; e += NT) {
        const int sh = e >> 13, el = e & 8191, dk = el >> 7, ch = 512 * 4 + sh;
        P.out[O_GLAS + e] = DEC[ch * 64 + dk] * P.in[2][e] + bf2f(DS[(size_t)ch * 8192 + el]);
    }
    for (int e = gid; e < 4096; e += NT) {
        const int bb = e >> 11, gp = e & 2047;
        const float ar = ((const float*)(tb + T_ABAR64))[gp * 2], ai = ((const float*)(tb + T_ABAR64))[gp * 2 + 1];
        const f32x2* E = (const f32x2*)(ws + WS_E); f32x2* XPv = (f32x2*)(ws + WS_XP);
        float xr = 0.f, xi = 0.f;
        for (int c = 0; c < 256; c += 8) {
            f32x2 v[8];
#pragma unroll
            for (int i = 0; i < 8; ++i) v[i] = E[(size_t)(bb * 256 + c + i) * 2048 + gp];
#pragma unroll
            for (int i = 0; i < 8; ++i) { XPv[(size_t)(bb * 256 + c + i) * 2048 + gp] = (f32x2){xr, xi};
                const float nxr = ar * xr - ai * xi + v[i].x, nxi = ar * xi + ai * xr + v[i].y; xr = nxr; xi = nxi; }
        }
        P.out[O_S5P + (size_t)e * 2] = xr; P.out[O_S5P + (size_t)e * 2 + 1] = xi;
    }
}

__global__ void __launch_bounds__(512, 2) fwd_kernel(Params P) {
    extern __shared__ __attribute__((aligned(16))) unsigned char smem[];
    LAS unsigned char* lds = (LAS unsigned char*)smem;
    cg::grid_group grid = cg::this_grid();
    unsigned char* ws = P.ws;
    const int lo = P.ph_lo, hi = P.ph_hi;
    const int G = gridDim.x, bx = blockIdx.x;
    const int tid = threadIdx.x, lane = tid & 63, wave = tid >> 6;
#define IN(k) (lo <= (k) && (k) < hi)
#define SEAM(k) do { if (IN(k) && IN((k) + 1)) { asm volatile("s_waitcnt vmcnt(0)" ::: "memory"); __syncthreads(); grid.sync(); \
        __builtin_amdgcn_fence(__ATOMIC_ACQUIRE, "agent"); asm volatile("s_waitcnt vmcnt(0)" ::: "memory"); __syncthreads(); } } while (0)
#define SEAM_X(k) do { if (IN(k) && IN((k) + 1)) { asm volatile("s_waitcnt vmcnt(0)" ::: "memory"); __syncthreads(); \
        ++xgen; if (tid == 0) { __hip_atomic_fetch_add(xbar, 1u, __ATOMIC_RELEASE, __HIP_MEMORY_SCOPE_AGENT); \
            const unsigned tgt = xgen * (unsigned)xm.nb; while (__hip_atomic_load(xbar, RLX_AGENT) < tgt) __builtin_amdgcn_s_sleep(2); } \
        __syncthreads(); __builtin_amdgcn_fence(__ATOMIC_ACQUIRE, "agent"); asm volatile("s_waitcnt vmcnt(0)" ::: "memory"); __syncthreads(); } } while (0)
    float* Y = P.out + O_Y;
    bf16_t* RB = (bf16_t*)(ws + WS_RB); bf16_t* ZB = (bf16_t*)(ws + WS_Z); bf16_t* ACT = ZB; bf16_t* GLU = (bf16_t*)(ws + WS_LA); bf16_t* TM = (bf16_t*)(ws + WS_R2);
    float* LA = (float*)(ws + WS_LA);
    float* SSX = (float*)(ws + WS_SSX); float* SSH = (float*)(ws + WS_SSH); float* SS2 = (float*)(ws + WS_SS2); float* SS3 = (float*)(ws + WS_SS3);

    const unsigned xcc_id = (unsigned)__builtin_amdgcn_s_getreg((3 << 11) | 20) & 0xFu;
    pg8::XMap xm;
    {
        unsigned* ctl = (unsigned*)(ws + WS_CTL) + 64 * (hi - lo == N_PHASES ? 0 : 1 + lo);
        LAS unsigned* lw = (LAS unsigned*)(lds + LDS_BYTES - 16);
        const unsigned xcc = xcc_id;
        if (tid == 0) { lw[0] = __hip_atomic_fetch_add(ctl + xcc, 1u, RLX_AGENT); lw[1] = xcc; }
        asm volatile("s_waitcnt vmcnt(0)" ::: "memory"); __syncthreads(); grid.sync(); __syncthreads();
        int nx = 0, xi = 0;
        for (int j = 0; j < 16; ++j) { const unsigned cj = __hip_atomic_load(ctl + j, RLX_AGENT); if (cj) { if (j < (int)lw[1]) ++xi; ++nx; } }
        xm.nx = nx; xm.xi = xi; xm.rank = (int)lw[0]; xm.nb = (int)__hip_atomic_load(ctl + lw[1], RLX_AGENT);
        __syncthreads();
    }
    const int NTX = pg8::xm_ntiles(xm, M / 256);
    unsigned xgen = 0;
    unsigned* xbar = (unsigned*)(ws + WS_CTL) + 1024 + 64 * xcc_id;
    if (IN(0)) p0_phase(P, lds, xm);
    SEAM(0);
    if (IN(1)) { pg8::Gemm g{RB, (const bf16_t*)(ws + WS_WGU1), M, 5632, 1024}; pg8::XcdOrder S; S.init(M, 5632, xm);
        EpiGated<false> E{ACT, FF, SSX, 1}; pg8::gemm_phase(lds, g, S, E); }
    SEAM_X(1);
    if (IN(2)) { pg8::Gemm g{ACT, (const bf16_t*)(ws + WS_WD1), M, 1024, FF}; pg8::XcdOrder S; S.init(M, 1024, xm);
        EpiRes E{P.in[0], P.in[1], Y, RB, SSH, 0.5f}; pg8::gemm_phase(lds, g, S, E); }
    SEAM_X(2);
    if (IN(3)) { pg8::Gemm g{RB, (const bf16_t*)(ws + WS_WIN), M, NZ, 1024}; pg8::XcdOrder S; S.init(M, NZ, xm);
        EpiZ E{ZB, LA, SSH, P.in[11]}; pg8::gemm_phase(lds, g, S, E); }
    SEAM_X(3);
    for (int rep = 0; rep < TIMING_REP_MIXER; ++rep) {
    if (IN(4)) {
        for (int u = xm.rank; u < NTX * 16; u += xm.nb) gla_local(P, lds, (xm.xi + (u >> 4) * xm.nx) * 4 + ((u >> 2) & 3), u & 3);
        if (wave < S5_NW) s5_wave<false>(P, ws + WS_TBL + (size_t)xm.xi * TBL_STRIDE, lds + wave * S5_WAVE_LDS, xm, NTX, wave, lane);
    }
    SEAM(4);
    if (IN(5)) carry_phase(P, ws + WS_TBL + (size_t)xm.xi * TBL_STRIDE);
    SEAM(5);
    if (IN(6)) {
        for (int u = xm.rank; u < NTX * 16; u += xm.nb) gla_out(P, lds, (xm.xi + (u >> 4) * xm.nx) * 4 + ((u >> 2) & 3), u & 3);
        if (wave < S5_NW) s5_wave<true>(P, ws + WS_TBL + (size_t)xm.xi * TBL_STRIDE, lds + wave * S5_WAVE_LDS, xm, NTX, wave, lane);
        __syncthreads();
    }
    SEAM_X(6);
    }
    if (IN(7)) {
        { pg8::Gemm g{RB + (size_t)M * 512, (const bf16_t*)(ws + WS_WGLU), M, 1024, 512}; pg8::XcdOrder S; S.init(M, 1024, xm);
          EpiGated<true> E{GLU, 512, nullptr, 0}; pg8::gemm_phase(lds, g, S, E); }
        { pg8::Gemm g{RB, (const bf16_t*)(ws + WS_WGO), M, 1024, 512}; pg8::XcdOrder S; S.init(M, 1024, xm);
          EpiMix<false> E{TM, ZB, ZGG}; pg8::gemm_phase(lds, g, S, E); }
    }
    SEAM_X(7);
    if (IN(8)) { pg8::Gemm g{GLU, (const bf16_t*)(ws + WS_WS5O), M, 1024, 512}; pg8::XcdOrder S; S.init(M, 1024, xm);
        EpiMix<true> E{TM, ZB, ZG5}; pg8::gemm_phase(lds, g, S, E); }
    SEAM_X(8);
    if (IN(9)) { pg8::Gemm g{TM, (const bf16_t*)(ws + WS_WOUT), M, 1024, 1024}; pg8::XcdOrder S; S.init(M, 1024, xm);
        EpiRes E{Y, Y + (size_t)MP * 1024, Y, RB, SS2, 1.0f}; pg8::gemm_phase(lds, g, S, E); }
    SEAM_X(9);
    if (IN(10)) { pg8::Gemm g{RB, (const bf16_t*)(ws + WS_WGU2), M, 5632, 1024}; pg8::XcdOrder S; S.init(M, 5632, xm);
        EpiGated<false> E{ACT, FF, SS2, 16}; pg8::gemm_phase(lds, g, S, E); }
    SEAM_X(10);
    if (IN(11)) { pg8::Gemm g{ACT, (const bf16_t*)(ws + WS_WD2), M, 1024, FF}; pg8::XcdOrder S; S.init(M, 1024, xm);
        EpiRes E{Y, Y + (size_t)MP * 1024, Y, nullptr, SS3, 0.5f}; pg8::gemm_phase(lds, g, S, E); }
    SEAM_X(11);
    if (IN(12)) {
        const float* gf = P.in[30];
        for (int u = xm.rank * 8 + wave; u < NTX * 256; u += xm.nb * 8) {
            const int row = (xm.xi + (u >> 8) * xm.nx) * 256 + (u & 255);
            const float rs = row_rstd(SS3, 16, row);
            f32x4* yr = (f32x4*)(Y + (size_t)row * 1024);
#pragma unroll
            for (int j = 0; j < 4; ++j) { const f32x4 v = yr[lane + 64 * j], gg = ((const f32x4*)gf)[lane + 64 * j]; yr[lane + 64 * j] = v * rs * gg; }
        }
        asm volatile("s_waitcnt vmcnt(0)" ::: "memory"); __threadfence_system(); asm volatile("s_waitcnt vmcnt(0)" ::: "memory");
    }
}

extern "C" void kernel_launch(void* const* d_in, const int* in_sizes, int n_in, void* d_out, int out_size, void* d_ws, size_t ws_size, hipStream_t stream) {
    static int grid_blocks = 0;
    if (grid_blocks == 0) {
        if (n_in != 31 || ws_size < WS_END) { fprintf(stderr, "kernel_launch: need 31 inputs and >= %zu bytes of workspace; got %d, %zu\n", (size_t)WS_END, n_in, ws_size); grid_blocks = -1; return; }
        int dev = 0, cus = 0, per_cu = 0;
        hipGetDevice(&dev);
        hipDeviceGetAttribute(&cus, hipDeviceAttributeMultiprocessorCount, dev);
        if (hipFuncSetAttribute((const void*)fwd_kernel, hipFuncAttributeMaxDynamicSharedMemorySize, LDS_BYTES) != hipSuccess) { fprintf(stderr, "kernel_launch: hipFuncSetAttribute failed\n"); grid_blocks = -1; return; }
        if (hipOccupancyMaxActiveBlocksPerMultiprocessor(&per_cu, (const void*)fwd_kernel, 512, LDS_BYTES) != hipSuccess || per_cu < 1) { fprintf(stderr, "kernel_launch: occupancy query gave %d\n", per_cu); per_cu = 1; }
        (void)hipGetLastError();
        grid_blocks = cus * 1;
        fprintf(stderr, "kernel_launch: cus %d per_cu %d grid %d\n", cus, per_cu, grid_blocks);
    }
    if (grid_blocks < 0) return;
    hipMemsetAsync((unsigned char*)d_ws + WS_CTL, 0, 8192, stream);
    Params p{};
    for (int i = 0; i < 31; ++i) p.in[i] = (const float*)d_in[i];
    p.out = (float*)d_out; p.ws = (unsigned char*)d_ws;
    p.ph_lo = 0; p.ph_hi = N_PHASES;
    void* args[] = {&p};
    hipError_t e = hipLaunchCooperativeKernel((const void*)fwd_kernel, dim3(grid_blocks), dim3(512), args, LDS_BYTES, stream);
    if (e != hipSuccess) fprintf(stderr, "cooperative launch failed: %s (grid %d)\n", hipGetErrorString(e), grid_blocks);
}
```
